# Optimizing an MI355X kernel written in HIP

```python
import math
import jax, jax.numpy as jnp
from jax import lax
import numpy as np

D_MODEL = 1024
BATCH = 8
SEQ = 4096
DEPTH = 1

GRID_W = 64
CTX_LEN = 256
N_MOD = 9
D_FF = 2816
MLA_HEADS = 12
QK_NOPE = 64
QK_ROPE = 32
V_HEAD = 64
Q_RANK = 256
KV_RANK = 128
MLA_WIDTH = MLA_HEADS * V_HEAD
SSM_GROUPS = 16
SSM_CH = 16
SSM_WIDTH = SSM_GROUPS * SSM_CH
SSM_STATE = 64
D_MIX = MLA_WIDTH + SSM_WIDTH
D_IN = Q_RANK + KV_RANK + QK_ROPE + SSM_WIDTH
ROPE_BASE = 10000.0
ATTN_SCALE = (QK_NOPE + QK_ROPE) ** -0.5
Q_BLOCK = 128
EPS = 1e-6
DT_MIN = 1e-3
DT_MAX = 1e-1

kernel_name = "hymba_mla_s5_macaron_dit"


def rmsnorm(x, g):
    xf = x.astype(jnp.float32)
    y = xf * lax.rsqrt(jnp.mean(xf * xf, axis=-1, keepdims=True) + EPS)
    return (y * g.astype(jnp.float32)).astype(x.dtype)


def adaln(cvec, w_mod, b_mod):
    m = jax.nn.silu(cvec) @ w_mod + b_mod
    m = m.reshape(cvec.shape[0], 1, N_MOD, D_MODEL)
    return [m[:, :, i] for i in range(N_MOD)]


def modulate(x, g, shift, scale):
    return rmsnorm(x, g) * (1.0 + scale) + shift


def swiglu(h, w_gu, w_down):
    gate, up = jnp.split(h @ w_gu, 2, axis=-1)
    return (jax.nn.silu(gate) * up) @ w_down


def axial_rope_tables(n_tokens, dtype):
    rows = n_tokens // GRID_W
    row = jnp.repeat(jnp.arange(rows), GRID_W).astype(jnp.float32)
    col = jnp.tile(jnp.arange(GRID_W), rows).astype(jnp.float32)
    per_axis = QK_ROPE // 2
    inv_freq = ROPE_BASE ** (-jnp.arange(0, per_axis, 2, dtype=jnp.float32) / per_axis)
    ang = jnp.concatenate([row[:, None] * inv_freq, col[:, None] * inv_freq], axis=-1)
    return jnp.cos(ang).astype(dtype), jnp.sin(ang).astype(dtype)


def apply_rope(t, cos, sin):
    tp = t.reshape(t.shape[:-1] + (t.shape[-1] // 2, 2))
    t1, t2 = tp[..., 0], tp[..., 1]
    return jnp.stack([t1 * cos - t2 * sin, t1 * sin + t2 * cos], axis=-1).reshape(t.shape)


def project(h, w_in, g_cq, w_uq, g_ckv, w_ukv):
    bsz, n = h.shape[:2]
    p = h @ w_in
    c_q, c_kv, k_rope, u = jnp.split(p, [Q_RANK, Q_RANK + KV_RANK, Q_RANK + KV_RANK + QK_ROPE], axis=-1)
    q = (rmsnorm(c_q, g_cq) @ w_uq).reshape(bsz, n, MLA_HEADS, QK_NOPE + QK_ROPE)
    kv = (rmsnorm(c_kv, g_ckv) @ w_ukv).reshape(bsz, n, MLA_HEADS, QK_NOPE + V_HEAD)
    q_nope, q_rope = jnp.split(q, [QK_NOPE], axis=-1)
    k_nope, v = jnp.split(kv, [QK_NOPE], axis=-1)
    return q_nope, q_rope, k_nope, v, k_rope, u


def attend(q_nope, q_rope, k_nope, k_rope, v):
    s = (jnp.einsum('bqhd,bkhd->bhqk', q_nope, k_nope)
         + jnp.einsum('bqhr,bkr->bhqk', q_rope, k_rope)).astype(jnp.float32) * ATTN_SCALE
    p = jax.nn.softmax(s, axis=-1).astype(v.dtype)
    return jnp.einsum('bhqk,bkhd->bqhd', p, v)


def latent_attention(q_nope, q_rope, k_nope, k_rope, v):
    bsz, n = q_nope.shape[:2]
    nblk = n // Q_BLOCK

    def blocks(t):
        return t.reshape((bsz, nblk, Q_BLOCK) + t.shape[2:]).swapaxes(0, 1)

    o = lax.map(lambda q: attend(q[0], q[1], k_nope, k_rope, v), (blocks(q_nope), blocks(q_rope)))
    return o.swapaxes(0, 1).reshape(bsz, n, MLA_WIDTH)


def s5_discretize(lam_re, lam_im, log_dt, b_re, b_im):
    dt = jnp.exp(log_dt.astype(jnp.float32))[:, None]
    lr = jnp.minimum(lam_re.astype(jnp.float32), -1e-4)
    li = lam_im.astype(jnp.float32)
    mag = jnp.exp(lr * dt)
    ar, ai = mag * jnp.cos(li * dt), mag * jnp.sin(li * dt)
    den = lr * lr + li * li
    fr = ((ar - 1.0) * lr + ai * li) / den
    fi = (ai * lr - (ar - 1.0) * li) / den
    br, bi = b_re.astype(jnp.float32), b_im.astype(jnp.float32)
    bbr = fr[..., None] * br - fi[..., None] * bi
    bbi = fr[..., None] * bi + fi[..., None] * br
    return ar, ai, bbr, bbi


def complex_scan(ar, ai, br, bi, reverse):
    n = br.shape[1]
    a_r = jnp.broadcast_to(ar, (1, n) + ar.shape)
    a_i = jnp.broadcast_to(ai, (1, n) + ai.shape)

    def combine(e1, e2):
        a1r, a1i, b1r, b1i = e1
        a2r, a2i, b2r, b2i = e2
        return (a2r * a1r - a2i * a1i, a2r * a1i + a2i * a1r,
                a2r * b1r - a2i * b1i + b2r, a2r * b1i + a2i * b1r + b2i)

    return lax.associative_scan(combine, (a_r, a_i, br, bi), reverse=reverse, axis=1)


def s5_drive(u, bbr, bbi):
    return jnp.einsum('btgc,gpc->btgp', u, bbr), jnp.einsum('btgc,gpc->btgp', u, bbi)


def s5_readout(xr, xi, c_re, c_im):
    return (jnp.einsum('btgp,gcp->btgc', xr, c_re.astype(jnp.float32))
            - jnp.einsum('btgp,gcp->btgc', xi, c_im.astype(jnp.float32)))


def s5_glu(y, w_glu, dtype):
    bsz, n = y.shape[:2]
    z = jax.nn.gelu(y.reshape(bsz, n, SSM_WIDTH))
    a, g = jnp.split(z @ w_glu.astype(jnp.float32), 2, axis=-1)
    return (a * jax.nn.sigmoid(g)).astype(dtype)


def s5_branch(u_c, u_x, lam_re, lam_im, log_dt, b_re, b_im, c_re, c_im, d_skip, w_glu, with_ctx_out):
    bsz = u_x.shape[0]
    uc = u_c.reshape(bsz, u_c.shape[1], SSM_GROUPS, SSM_CH).astype(jnp.float32)
    ux = u_x.reshape(bsz, u_x.shape[1], SSM_GROUPS, SSM_CH).astype(jnp.float32)
    dsk = d_skip.reshape(SSM_GROUPS, SSM_CH).astype(jnp.float32)
    y_x = ux * dsk
    y_c = uc * dsk
    for d, rev in ((0, False), (1, True)):
        ar, ai, bbr, bbi = s5_discretize(lam_re[d], lam_im[d], log_dt[d], b_re[d], b_im[d])
        bcr, bci = s5_drive(uc, bbr, bbi)
        _, _, xcr, xci = complex_scan(ar, ai, bcr, bci, rev)
        end = 0 if rev else -1
        h0r, h0i = xcr[:, end][:, None], xci[:, end][:, None]
        bxr, bxi = s5_drive(ux, bbr, bbi)
        apr, api, xr, xi = complex_scan(ar, ai, bxr, bxi, rev)
        xr, xi = xr + apr * h0r - api * h0i, xi + apr * h0i + api * h0r
        y_x = y_x + s5_readout(xr, xi, c_re[d], c_im[d])
        if with_ctx_out:
            y_c = y_c + s5_readout(xcr, xci, c_re[d], c_im[d])
    out_x = s5_glu(y_x, w_glu, u_x.dtype)
    out_c = s5_glu(y_c, w_glu, u_c.dtype) if with_ctx_out else None
    return out_x, out_c


def hybrid_mixer(hx, hc, cos, sin, w_in, g_cq, w_uq, g_ckv, w_ukv, lam_re, lam_im, log_dt,
                 b_re, b_im, c_re, c_im, d_skip, w_glu, g_mla_out, g_ssm_out, w_out, with_ctx_out):
    bsz, n = hx.shape[:2]
    qn_x, qr_x, kn_x, v_x, kr_x, u_x = project(hx, w_in, g_cq, w_uq, g_ckv, w_ukv)
    qn_c, qr_c, kn_c, v_c, kr_c, u_c = project(hc, w_in, g_cq, w_uq, g_ckv, w_ukv)
    qr_x = apply_rope(qr_x, cos[:, None, :], sin[:, None, :])
    kr_x = apply_rope(kr_x, cos, sin)
    kn_all = jnp.concatenate([kn_c, kn_x], axis=1)
    kr_all = jnp.concatenate([kr_c, kr_x], axis=1)
    v_all = jnp.concatenate([v_c, v_x], axis=1)
    attn_x = latent_attention(qn_x, qr_x, kn_all, kr_all, v_all)
    ssm_x, ssm_c = s5_branch(u_c, u_x, lam_re, lam_im, log_dt, b_re, b_im, c_re, c_im,
                             d_skip, w_glu, with_ctx_out)
    out_x = jnp.concatenate([rmsnorm(attn_x, g_mla_out), rmsnorm(ssm_x, g_ssm_out)], axis=-1) @ w_out
    out_c = None
    if with_ctx_out:
        attn_c = attend(qn_c, qr_c, kn_c, kr_c, v_c).reshape(bsz, hc.shape[1], MLA_WIDTH)
        out_c = jnp.concatenate([rmsnorm(attn_c, g_mla_out), rmsnorm(ssm_c, g_ssm_out)], axis=-1) @ w_out
    return out_x, out_c


def setup_inputs(seed: int = 0) -> dict:
    key = jax.random.key(seed)
    ks = jax.random.split(key, 32)
    f32 = jnp.float32
    L = DEPTH

    def nrm(k, shape, s):
        return jax.random.normal(k, shape, f32) * s

    def gain(k, shape):
        return 1.0 + 0.01 * jax.random.normal(k, shape, f32)

    n_idx = jnp.arange(SSM_STATE, dtype=f32)
    ssm_shape = (L, 2, SSM_GROUPS, SSM_STATE)
    return {
        "x": nrm(ks[0], (BATCH, SEQ, D_MODEL), 1.0),
        "c": nrm(ks[1], (BATCH, D_MODEL), 1.0),
        "ctx": nrm(ks[2], (BATCH, CTX_LEN, D_MODEL), 1.0),
        "c_ctx": nrm(ks[3], (D_MODEL,), 1.0),
        "w_mod": nrm(ks[4], (L, D_MODEL, N_MOD * D_MODEL), 0.5 * D_MODEL ** -0.5),
        "b_mod": nrm(ks[5], (L, N_MOD * D_MODEL), 0.01),
        "g_ffn1": gain(ks[6], (L, D_MODEL)),
        "w_gu1": nrm(ks[7], (L, D_MODEL, 2 * D_FF), D_MODEL ** -0.5),
        "w_down1": nrm(ks[8], (L, D_FF, D_MODEL), D_FF ** -0.5),
        "g_mix": gain(ks[9], (L, D_MODEL)),
        "w_in": nrm(ks[10], (L, D_MODEL, D_IN), D_MODEL ** -0.5),
        "g_cq": gain(ks[11], (L, Q_RANK)),
        "w_uq": nrm(ks[12], (L, Q_RANK, MLA_HEADS * (QK_NOPE + QK_ROPE)), Q_RANK ** -0.5),
        "g_ckv": gain(ks[13], (L, KV_RANK)),
        "w_ukv": nrm(ks[14], (L, KV_RANK, MLA_HEADS * (QK_NOPE + V_HEAD)), KV_RANK ** -0.5),
        "lam_re": -0.5 + nrm(ks[15], ssm_shape, 0.01),
        "lam_im": math.pi * n_idx + nrm(ks[16], ssm_shape, 0.01),
        "log_dt": jax.random.uniform(ks[17], (L, 2, SSM_GROUPS), f32, math.log(DT_MIN), math.log(DT_MAX)),
        "b_re": nrm(ks[18], (L, 2, SSM_GROUPS, SSM_STATE, SSM_CH), (2 * SSM_CH) ** -0.5),
        "b_im": nrm(ks[19], (L, 2, SSM_GROUPS, SSM_STATE, SSM_CH), (2 * SSM_CH) ** -0.5),
        "c_re": nrm(ks[20], (L, 2, SSM_GROUPS, SSM_CH, SSM_STATE), SSM_STATE ** -0.5),
        "c_im": nrm(ks[21], (L, 2, SSM_GROUPS, SSM_CH, SSM_STATE), SSM_STATE ** -0.5),
        "d_skip": nrm(ks[22], (L, SSM_WIDTH), 1.0),
        "w_glu": nrm(ks[23], (L, SSM_WIDTH, 2 * SSM_WIDTH), SSM_WIDTH ** -0.5),
        "g_mla_out": gain(ks[24], (L, MLA_WIDTH)),
        "g_ssm_out": gain(ks[25], (L, SSM_WIDTH)),
        "w_out": nrm(ks[26], (L, D_MIX, D_MODEL), D_MIX ** -0.5),
        "g_ffn2": gain(ks[27], (L, D_MODEL)),
        "w_gu2": nrm(ks[28], (L, D_MODEL, 2 * D_FF), D_MODEL ** -0.5),
        "w_down2": nrm(ks[29], (L, D_FF, D_MODEL), D_FF ** -0.5),
        "g_final": gain(ks[30], (D_MODEL,)),
    }


def reference(x, c, ctx, c_ctx, w_mod, b_mod, g_ffn1, w_gu1, w_down1, g_mix, w_in, g_cq, w_uq,
              g_ckv, w_ukv, lam_re, lam_im, log_dt, b_re, b_im, c_re, c_im, d_skip, w_glu,
              g_mla_out, g_ssm_out, w_out, g_ffn2, w_gu2, w_down2, g_final):
    cos, sin = axial_rope_tables(x.shape[1], x.dtype)
    for l in range(DEPTH):
        last = l == DEPTH - 1
        mx = adaln(c, w_mod[l], b_mod[l])
        mc = adaln(c_ctx[None], w_mod[l], b_mod[l])
        x = x + 0.5 * mx[2] * swiglu(modulate(x, g_ffn1[l], mx[0], mx[1]), w_gu1[l], w_down1[l])
        ctx = ctx + 0.5 * mc[2] * swiglu(modulate(ctx, g_ffn1[l], mc[0], mc[1]), w_gu1[l], w_down1[l])
        hx = modulate(x, g_mix[l], mx[3], mx[4])
        hc = modulate(ctx, g_mix[l], mc[3], mc[4])
        mix_x, mix_c = hybrid_mixer(hx, hc, cos, sin, w_in[l], g_cq[l], w_uq[l], g_ckv[l], w_ukv[l],
                                    lam_re[l], lam_im[l], log_dt[l], b_re[l], b_im[l], c_re[l], c_im[l],
                                    d_skip[l], w_glu[l], g_mla_out[l], g_ssm_out[l], w_out[l],
                                    not last)
        x = x + mx[5] * mix_x
        x = x + 0.5 * mx[8] * swiglu(modulate(x, g_ffn2[l], mx[6], mx[7]), w_gu2[l], w_down2[l])
        if not last:
            ctx = ctx + mc[5] * mix_c
            ctx = ctx + 0.5 * mc[8] * swiglu(modulate(ctx, g_ffn2[l], mc[6], mc[7]), w_gu2[l], w_down2[l])
    return rmsnorm(x, g_final)
```

```cpp
#include <hip/hip_runtime.h>
#include <hip/hip_cooperative_groups.h>
#include <cstdio>
#include <cstdint>
namespace cg = cooperative_groups;

#ifndef MK_ONE_LAUNCH
#define MK_ONE_LAUNCH 1
#endif

constexpr int DM = 1024, NB = 8, SEQ = 4096, CTXL = 256, NLAT = NB * SEQ, NCTX = NB * CTXL, MT = NLAT + NCTX;
constexpr int DFF = 2816, NMODV = 9 * DM;
constexpr int NH = 12, DQK = 96, DV = 64, SKV = CTXL + SEQ;
constexpr int DINP = 768;
constexpr float EPS = 1e-6f;
constexpr float QSCALE = 0.10206207261596577f * 1.4426950408889634f;
constexpr int SG = 16, SC = 16, SP = 64, CH = 64;
constexpr int AUR = 768, AUK = 1280;

__device__ __forceinline__ int tid_fresh() { int t = threadIdx.x; asm volatile("" : "+v"(t)); return t; }
namespace pg8 {
#define PG8_LAS __attribute__((address_space(3)))
typedef unsigned short bf16_t;
typedef short bf16x8 __attribute__((ext_vector_type(8)));
typedef float f32x4 __attribute__((ext_vector_type(4)));
typedef float f32x2 __attribute__((ext_vector_type(2)));
typedef unsigned u32x4 __attribute__((ext_vector_type(4)));
constexpr int BM = 256, BK = 64, HALF = 128, HTB = HALF * BK * 2, STAGE_BYTES = 8 * HTB, NXCD = 8, WGM = 8;
__host__ __device__ __forceinline__ int lds_byte(int r, int c) { const int st = (r >> 4) * 2 + (c >> 5), rr = r & 15, cc = c & 31, ob = rr * 64 + cc * 2; return st * 1024 + (ob ^ (((ob >> 9) & 1) << 5)); }
__host__ __device__ __forceinline__ void stage_rc(int b, int& R, int& C) { const int st = b / 1024, sb = b % 1024, swz = sb ^ (((sb >> 9) & 1) << 5); R = (st >> 1) * 16 + swz / 64; C = (st & 1) * 32 + (swz % 64) / 2; }
__host__ __device__ __forceinline__ int perm32(int rho) { const int n = rho >> 4, i = rho & 15; return 8 * (i >> 2) + 4 * n + (i & 3); }
struct Unit { int pm, pn; };
struct Gemm { const bf16_t* A; const bf16_t* Bt; int K, lda, ldb; };
struct StaticOrder {
    int nM, nN, nwg, G, c;
    __device__ void init(int M, int N, int G_, int c_) { nM = M / BM; nN = N / BM; nwg = nM * nN; G = G_; c = c_; }
    __device__ bool next(int i, Unit& u) const {
        const long L = (long)i * G + c; if (L >= nwg) return false;
        int wgid = (int)L; { const int q = nwg / NXCD, r = nwg % NXCD, xcd = wgid % NXCD, off = wgid / NXCD; wgid = (xcd < r ? xcd * (q + 1) : r * (q + 1) + (xcd - r) * q) + off; }
        const int nig = WGM * nN, gid = wgid / nig, fm = gid * WGM, gsz = (nM - fm) < WGM ? (nM - fm) : WGM;
        u.pm = fm + ((wgid % nig) % gsz); u.pn = (wgid % nig) / gsz; return true;
    }
};
struct OrderE { int G, c; __device__ bool next(int i, Unit& u) const { const int L = i * G + c; if (L >= SG * 3) return false; const int g = L / 3; u.pm = 3 * g + L % 3; u.pn = g; return true; } };
struct OrderY { int G, c; __device__ bool next(int i, Unit& u) const { const int L = i * G + c; if (L >= SG * 8) return false; const int g = L >> 3, r = L & 7; u.pm = 3 * g + (r >> 2); u.pn = 4 * g + (r & 3); return true; } };

__device__ __forceinline__ unsigned cvt_pk_bf16(float lo, float hi) { unsigned r; asm volatile("v_cvt_pk_bf16_f32 %0, %1, %2" : "=v"(r) : "v"(lo), "v"(hi)); return r; }

template <class Epi, class Sched, bool ALIGN_EPI>
__device__ __forceinline__ void gemm_phase(PG8_LAS unsigned char* lds, const Gemm g, const Sched& S, const Epi& E) {
    const int tid = tid_fresh(), wid = __builtin_amdgcn_readfirstlane(tid >> 6), lane = tid & 63, wr = wid >> 2, wc = wid & 3, fr = lane & 15, fq = lane >> 4;
    int K_ = g.K; asm volatile("" : "+s"(K_));
    const int K = K_, nt = K / BK;
    unsigned voffA[2], voffB[2];
#pragma unroll
    for (int i = 0; i < 2; ++i) { int R, C; stage_rc(tid * 16 + i * 8192, R, C); const int Rb = Epi::PERM ? ((R & ~31) + perm32(R & 31)) : R;
        voffA[i] = (unsigned)(R * g.lda + C) * 2u; voffB[i] = (unsigned)(Rb * g.ldb + C) * 2u; }
    const size_t kstep = (size_t)(BK * 2);
    const size_t hA = (size_t)HALF * g.lda * 2, hB = (size_t)HALF * g.ldb * 2, tA = 2 * hA, tB = 2 * hB;
    const unsigned ldsw = (unsigned)wid * 1024u;
    const int aoff = lds_byte(wr * 64 + fr, fq * 8), boff = lds_byte(wc * 32 + fr, fq * 8);
#define PG8_SA(b, h) (((b) * 2 + (h)) * HTB)
#define PG8_SB(b, h) ((4 + (b) * 2 + (h)) * HTB)
#define PG8_STAGE(bufoff, gbase, voff) do { _Pragma("unroll") for (int _i = 0; _i < 2; ++_i) \
        __builtin_amdgcn_global_load_lds((const unsigned*)((const char*)(gbase) + (voff)[_i]), (PG8_LAS unsigned*)(lds + (bufoff) + ldsw + _i * 8192), 16, 0, 0); } while (0)
#define PG8_LDA(dst, b, h) do { _Pragma("unroll") for (int m = 0; m < 4; ++m) _Pragma("unroll") for (int k = 0; k < 2; ++k) dst[m][k] = *(const PG8_LAS bf16x8*)(lds + PG8_SA(b, h) + aoff + m * 2048 + k * 1024); } while (0)
#define PG8_LDB(dst, b, h) do { _Pragma("unroll") for (int n = 0; n < 2; ++n) _Pragma("unroll") for (int k = 0; k < 2; ++k) dst[n][k] = *(const PG8_LAS bf16x8*)(lds + PG8_SB(b, h) + boff + n * 2048 + k * 1024); } while (0)
#define PG8_MMA(ai, bj, At, Bt) do { __builtin_amdgcn_s_setprio(1); _Pragma("unroll") for (int m = 0; m < 4; ++m) _Pragma("unroll") for (int n = 0; n < 2; ++n) _Pragma("unroll") for (int k = 0; k < 2; ++k) \
        acc[ai][bj][m][n] = __builtin_amdgcn_mfma_f32_16x16x32_bf16(Bt[n][k], At[m][k], acc[ai][bj][m][n], 0, 0, 0); __builtin_amdgcn_s_setprio(0); } while (0)
#define PG8_WAIT_V(n) asm volatile("s_waitcnt vmcnt(" #n ")" ::: "memory")
#define PG8_WAIT_L(n) asm volatile("s_waitcnt lgkmcnt(" #n ")" ::: "memory")
#define PG8_BAR __builtin_amdgcn_s_barrier()
#define PG8_SCHED __builtin_amdgcn_sched_barrier(0)
    Unit cur, nxt; int ui = 0;
    if (!S.next(0, cur)) return;
    f32x4 acc[2][2][4][2];
#pragma unroll
    for (int a = 0; a < 2; ++a)
#pragma unroll
        for (int b = 0; b < 2; ++b)
#pragma unroll
            for (int m = 0; m < 4; ++m)
#pragma unroll
                for (int n = 0; n < 2; ++n) acc[a][b][m][n] = (f32x4){0.f, 0.f, 0.f, 0.f};
    bf16x8 At[4][2], B0[2][2], B1[2][2];
    const char* cA = (const char*)g.A + (size_t)cur.pm * tA; const char* cB = (const char*)g.Bt + (size_t)cur.pn * tB;
    PG8_STAGE(PG8_SB(0, 0), cB, voffB); PG8_STAGE(PG8_SB(0, 1), cB + hB, voffB); PG8_STAGE(PG8_SA(0, 0), cA, voffA); PG8_STAGE(PG8_SA(0, 1), cA + hA, voffA);
    if (wr == 1) PG8_BAR;
    PG8_WAIT_V(2); PG8_BAR;
    PG8_STAGE(PG8_SB(1, 0), cB + kstep, voffB); PG8_STAGE(PG8_SA(1, 0), cA + kstep, voffA); PG8_STAGE(PG8_SB(1, 1), cB + hB + kstep, voffB);
    PG8_WAIT_V(6); PG8_BAR;
    for (;;) {
        const bool has_next = S.next(ui + 1, nxt);
        const char* nA = has_next ? (const char*)g.A + (size_t)nxt.pm * tA : cA; const char* nB = has_next ? (const char*)g.Bt + (size_t)nxt.pn * tB : cB;
        for (int t = 0; t < nt; t += 2) {
            const bool last = (t == nt - 2);
            const char* a1 = cA + (size_t)(t + 1) * kstep;
            const char* a2 = last ? nA : cA + (size_t)(t + 2) * kstep; const char* b2 = last ? nB : cB + (size_t)(t + 2) * kstep;
            const char* a3 = a2 + kstep; const char* b3 = b2 + kstep;
            PG8_LDB(B0, 0, 0); PG8_LDB(B1, 0, 1); PG8_SCHED; PG8_LDA(At, 0, 0); PG8_STAGE(PG8_SA(1, 1), a1 + hA, voffA);
            PG8_WAIT_V(8); PG8_WAIT_L(0); PG8_BAR; PG8_MMA(0, 0, At, B0); PG8_MMA(0, 1, At, B1); PG8_BAR; PG8_SCHED;
            PG8_LDA(At, 0, 1); PG8_STAGE(PG8_SB(0, 0), b2, voffB); PG8_STAGE(PG8_SB(0, 1), b2 + hB, voffB); PG8_STAGE(PG8_SA(0, 0), a2, voffA);
            PG8_WAIT_V(8); PG8_WAIT_L(0); PG8_BAR; PG8_MMA(1, 0, At, B0); PG8_MMA(1, 1, At, B1); PG8_BAR; PG8_SCHED;
            PG8_LDB(B0, 1, 0); PG8_LDB(B1, 1, 1); PG8_SCHED; PG8_LDA(At, 1, 0); PG8_STAGE(PG8_SA(0, 1), a2 + hA, voffA);
            PG8_WAIT_V(8); PG8_WAIT_L(0); PG8_BAR; PG8_MMA(0, 0, At, B0); PG8_MMA(0, 1, At, B1); PG8_BAR; PG8_SCHED;
            PG8_LDA(At, 1, 1); PG8_STAGE(PG8_SB(1, 0), b3, voffB); PG8_STAGE(PG8_SB(1, 1), b3 + hB, voffB); PG8_STAGE(PG8_SA(1, 0), a3, voffA);
            PG8_WAIT_V(8); PG8_WAIT_L(0); PG8_BAR; PG8_MMA(1, 0, At, B0); PG8_MMA(1, 1, At, B1); PG8_BAR; PG8_SCHED;
        }
        if constexpr (ALIGN_EPI) { if (wr == 0) PG8_BAR; }
        E(acc, cur, wr, wc, fr, fq);
        if (!has_next) break;
#pragma unroll
        for (int a = 0; a < 2; ++a)
#pragma unroll
            for (int b = 0; b < 2; ++b)
#pragma unroll
                for (int m = 0; m < 4; ++m)
#pragma unroll
                    for (int n = 0; n < 2; ++n) acc[a][b][m][n] = (f32x4){0.f, 0.f, 0.f, 0.f};
        cur = nxt; cA = nA; cB = nB; ++ui;
        if constexpr (ALIGN_EPI) { if (wr == 1) PG8_BAR; }
    }
    PG8_WAIT_V(0);
    if constexpr (!ALIGN_EPI) { if (wr == 0) PG8_BAR; }
    PG8_BAR;
#undef PG8_SA
#undef PG8_SB
#undef PG8_STAGE
#undef PG8_LDA
#undef PG8_LDB
#undef PG8_MMA
#undef PG8_WAIT_V
#undef PG8_WAIT_L
#undef PG8_BAR
#undef PG8_SCHED
}

__device__ __forceinline__ float sigmoidf_fast(float x) { return __builtin_amdgcn_rcpf(1.0f + __builtin_amdgcn_exp2f(-1.4426950408889634f * x)); }

struct EpiSwiGLU {
    static constexpr bool PERM = true;
    bf16_t* H; int ldh;
    __device__ __forceinline__ void operator()(const f32x4 (&acc)[2][2][4][2], const Unit& u, int wr, int wc, int fr, int fq) const {
        const int row0 = u.pm * BM + wr * 64 + fr, col0 = u.pn * HALF + wc * 32 + 8 * fq;
#pragma unroll
        for (int ai = 0; ai < 2; ++ai)
#pragma unroll
            for (int m = 0; m < 4; ++m) { bf16_t* rowp = H + (size_t)(row0 + ai * HALF + m * 16) * ldh + col0;
                float h[8];
#pragma unroll
                for (int n = 0; n < 2; ++n)
#pragma unroll
                    for (int j = 0; j < 4; ++j) { const float gt = acc[ai][0][m][n][j], up = acc[ai][1][m][n][j]; h[4 * n + j] = gt * sigmoidf_fast(gt) * up; }
                u32x4 w; w.x = cvt_pk_bf16(h[0], h[1]); w.y = cvt_pk_bf16(h[2], h[3]); w.z = cvt_pk_bf16(h[4], h[5]); w.w = cvt_pk_bf16(h[6], h[7]);
                *(u32x4*)rowp = w; }
    }
};
struct EpiResid {
    static constexpr bool PERM = false;
    const float* base; float* out; const float* cbase; float* cout; const float* gate; float coef;
    __device__ __forceinline__ void operator()(const f32x4 (&acc)[2][2][4][2], const Unit& u, int wr, int wc, int fr, int fq) const {
        const bool isc = u.pm >= NLAT / BM; const int mrow = isc ? NB : (u.pm >> 4);
        const float* bs = isc ? cbase - (size_t)NLAT * DM : base; float* os = isc ? cout - (size_t)NLAT * DM : out;
        const int row0 = u.pm * BM + wr * 64 + fr, col0 = u.pn * BM + wc * 32 + 4 * fq;
        f32x4 gv[2][2];
#pragma unroll
        for (int bj = 0; bj < 2; ++bj)
#pragma unroll
            for (int n = 0; n < 2; ++n) gv[bj][n] = *(const f32x4*)(gate + (size_t)mrow * NMODV + col0 + bj * HALF + n * 16) * coef;
#pragma unroll
        for (int ai = 0; ai < 2; ++ai)
#pragma unroll
            for (int m = 0; m < 4; ++m) { const size_t off = (size_t)(row0 + ai * HALF + m * 16) * DM + col0;
#pragma unroll
                for (int bj = 0; bj < 2; ++bj)
#pragma unroll
                    for (int n = 0; n < 2; ++n) { const f32x4 b = *(const f32x4*)(bs + off + bj * HALF + n * 16); *(f32x4*)(os + off + bj * HALF + n * 16) = b + gv[bj][n] * acc[ai][bj][m][n]; } }
    }
};
struct EpiF32 {
    static constexpr bool PERM = false;
    float* C; int ldc; int tile_cols;
    __device__ __forceinline__ void operator()(const f32x4 (&acc)[2][2][4][2], const Unit& u, int wr, int wc, int fr, int fq) const {
        const int row0 = u.pm * BM + wr * 64 + fr, col0 = (tile_cols ? 0 : u.pn * BM) + wc * 32 + 4 * fq;
#pragma unroll
        for (int ai = 0; ai < 2; ++ai)
#pragma unroll
            for (int m = 0; m < 4; ++m) { float* rowp = C + (size_t)(row0 + ai * HALF + m * 16) * ldc + col0;
#pragma unroll
                for (int bj = 0; bj < 2; ++bj)
#pragma unroll
                    for (int n = 0; n < 2; ++n) *(f32x4*)(rowp + bj * HALF + n * 16) = acc[ai][bj][m][n]; }
    }
};
struct EpiQ {
    static constexpr bool PERM = true;
    bf16_t* Q; const float* rope;
    __device__ __forceinline__ void operator()(const f32x4 (&acc)[2][2][4][2], const Unit& u, int wr, int wc, int fr, int fq) const {
        const int row0 = u.pm * BM + wr * 64 + fr, b = row0 >> 12, t0 = row0 & (SEQ - 1);
#pragma unroll
        for (int bj = 0; bj < 2; ++bj) { const int col8 = u.pn * BM + bj * HALF + wc * 32 + 8 * fq; if (col8 >= NH * DQK) continue;
            const int h = col8 / DQK, d = col8 - h * DQK; const bool rp = d >= 64;
            const unsigned qoff = (unsigned)((((b * NH + h) * SEQ + t0) * DQK + d) * 2);
            const unsigned roff = (unsigned)((t0 * 16 + (rp ? ((d - 64) >> 1) : 0)) * 8);
#pragma unroll
            for (int ai = 0; ai < 2; ++ai)
#pragma unroll
                for (int m = 0; m < 4; ++m) { const unsigned dr = (unsigned)(ai * HALF + m * 16);
                    float v[8];
#pragma unroll
                    for (int n = 0; n < 2; ++n)
#pragma unroll
                        for (int j = 0; j < 4; ++j) v[4 * n + j] = acc[ai][bj][m][n][j] * QSCALE;
                    if (rp) { const float* cs = (const float*)((const char*)rope + (roff + dr * 128u)); const f32x4 c0 = *(const f32x4*)cs, c1 = *(const f32x4*)(cs + 4);
                        const float cc[4] = {c0[0], c0[2], c1[0], c1[2]}, ss[4] = {c0[1], c0[3], c1[1], c1[3]};
#pragma unroll
                        for (int i = 0; i < 4; ++i) { const float t1 = v[2 * i], t2 = v[2 * i + 1]; v[2 * i] = t1 * cc[i] - t2 * ss[i]; v[2 * i + 1] = t1 * ss[i] + t2 * cc[i]; } }
                    u32x4 w; w.x = cvt_pk_bf16(v[0], v[1]); w.y = cvt_pk_bf16(v[2], v[3]); w.z = cvt_pk_bf16(v[4], v[5]); w.w = cvt_pk_bf16(v[6], v[7]);
                    *(u32x4*)((char*)Q + (qoff + dr * (unsigned)(DQK * 2))) = w; asm volatile("" ::: "memory"); } }
    }
};
struct EpiKV {
    static constexpr bool PERM = true;
    bf16_t* Kf; bf16_t* Vf;
    __device__ __forceinline__ void operator()(const f32x4 (&acc)[2][2][4][2], const Unit& u, int wr, int wc, int fr, int fq) const {
        const int row0 = u.pm * BM + wr * 64 + fr; const bool isc = u.pm >= NLAT / BM; int b, key0;
        if (isc) { const int r = row0 - NLAT; b = r >> 8; key0 = r & (CTXL - 1); } else { b = row0 >> 12; key0 = CTXL + (row0 & (SEQ - 1)); }
        const bool isk = wc < 2; const int d = (wc & 1) * 32 + 8 * fq;
        char* basep = isk ? (char*)Kf : (char*)Vf; const unsigned rs = isk ? (unsigned)(DQK * 2) : (unsigned)(DV * 2);
#pragma unroll
        for (int bj = 0; bj < 2; ++bj) { const int h = u.pn * 2 + bj;
            const unsigned off = (unsigned)((b * NH + h) * SKV + key0) * rs + (unsigned)(d * 2);
#pragma unroll
            for (int ai = 0; ai < 2; ++ai)
#pragma unroll
                for (int m = 0; m < 4; ++m) { const unsigned dr = (unsigned)(ai * HALF + m * 16);
                    const f32x4 v0 = acc[ai][bj][m][0], v1 = acc[ai][bj][m][1];
                    u32x4 w; w.x = cvt_pk_bf16(v0[0], v0[1]); w.y = cvt_pk_bf16(v0[2], v0[3]); w.z = cvt_pk_bf16(v1[0], v1[1]); w.w = cvt_pk_bf16(v1[2], v1[3]);
                    *(u32x4*)(basep + (off + dr * rs)) = w; asm volatile("" ::: "memory"); } }
    }
};
struct EpiY {
    static constexpr bool PERM = true;
    bf16_t* Zs;
    __device__ __forceinline__ void operator()(const f32x4 (&acc)[2][2][4][2], const Unit& u, int wr, int wc, int fr, int fq) const {
        const int g = u.pn >> 2, rl0 = (u.pm - 3 * g) * BM + wr * 64 + fr;
#pragma unroll
        for (int bj = 0; bj < 2; ++bj) { const int coll = (u.pn & 3) * BM + bj * HALF + wc * 32 + 8 * fq, t = coll >> 4, co8 = coll & 15;
#pragma unroll
            for (int ai = 0; ai < 2; ++ai)
#pragma unroll
                for (int m = 0; m < 4; ++m) { const int rl = rl0 + ai * HALF + m * 16, b = rl >> 6, k = rl & 63; const size_t tok = (size_t)b * SEQ + k * CH + t;
                    float z[8];
#pragma unroll
                    for (int n = 0; n < 2; ++n)
#pragma unroll
                        for (int j = 0; j < 4; ++j) { const float x = acc[ai][bj][m][n][j]; const float in = 1.5957691216057308f * (x + 0.044715f * x * x * x); z[4 * n + j] = x * sigmoidf_fast(in); }
                    u32x4 w; w.x = cvt_pk_bf16(z[0], z[1]); w.y = cvt_pk_bf16(z[2], z[3]); w.z = cvt_pk_bf16(z[4], z[5]); w.w = cvt_pk_bf16(z[6], z[7]);
                    *(u32x4*)(Zs + tok * 256 + g * 16 + co8) = w; } }
    }
};
struct EpiGLU {
    static constexpr bool PERM = true;
    bf16_t* O; int ldo; int coff;
    __device__ __forceinline__ void operator()(const f32x4 (&acc)[2][2][4][2], const Unit& u, int wr, int wc, int fr, int fq) const {
        const int row0 = u.pm * BM + wr * 64 + fr, col0 = coff + u.pn * HALF + wc * 32 + 8 * fq;
#pragma unroll
        for (int ai = 0; ai < 2; ++ai)
#pragma unroll
            for (int m = 0; m < 4; ++m) { bf16_t* rowp = O + (size_t)(row0 + ai * HALF + m * 16) * ldo + col0;
                float h[8];
#pragma unroll
                for (int n = 0; n < 2; ++n)
#pragma unroll
                    for (int j = 0; j < 4; ++j) h[4 * n + j] = acc[ai][0][m][n][j] * sigmoidf_fast(acc[ai][1][m][n][j]);
                u32x4 w; w.x = cvt_pk_bf16(h[0], h[1]); w.y = cvt_pk_bf16(h[2], h[3]); w.z = cvt_pk_bf16(h[4], h[5]); w.w = cvt_pk_bf16(h[6], h[7]);
                *(u32x4*)rowp = w; }
    }
};
}

namespace att {
using bf16x8 = __attribute__((ext_vector_type(8))) short;
using s16x4  = __attribute__((ext_vector_type(4))) short;
using f32x16 = __attribute__((ext_vector_type(16))) float;
using u32x4  = __attribute__((ext_vector_type(4))) unsigned;
constexpr int NW = 8, QBLK = 32, KVBLK = 64, NT = SKV / KVBLK;
constexpr int KROW = 208;
constexpr int SHM_K = KVBLK * KROW, SHM_V = KVBLK * DV * 2;
constexpr int OFF_V = 0, OFF_K = 2 * SHM_V, OFF_WS = OFF_K + 2 * SHM_K, OFF_OST = OFF_WS + NW * 64 * 4, LDS_BYTES = OFF_OST + NW * 4096;
constexpr float THRL = 8.0f;
#define SBAR() __builtin_amdgcn_sched_barrier(0)
__device__ __forceinline__ int crow(int r, int hi) { return (r & 3) + 8 * (r >> 2) + 4 * hi; }
__device__ __forceinline__ unsigned cvtpk(float lo, float hi) { unsigned r; asm volatile("v_cvt_pk_bf16_f32 %0, %1, %2" : "=v"(r) : "v"(lo), "v"(hi)); return r; }
__device__ __forceinline__ void partialSM(f32x16& p0, f32x16& p1, float& m_reg, float& alpha) {
  float pmax = p0[0];
#pragma unroll
  for (int r = 1; r < 16; ++r) pmax = fmaxf(pmax, p0[r]);
#pragma unroll
  for (int r = 0; r < 16; ++r) pmax = fmaxf(pmax, p1[r]);
  { auto rr = __builtin_amdgcn_permlane32_swap(__float_as_uint(pmax), __float_as_uint(pmax), false, false);
    pmax = fmaxf(__uint_as_float(rr[0]), __uint_as_float(rr[1])); }
  float mn;
  if (__builtin_expect(__all(pmax - m_reg <= THRL), 1)) { mn = m_reg; alpha = 1.f; }
  else { mn = fmaxf(m_reg, pmax); alpha = __builtin_amdgcn_exp2f(m_reg - mn); m_reg = mn; }
#pragma unroll
  for (int r = 0; r < 16; ++r) { p0[r] -= mn; p1[r] -= mn; }
#pragma unroll
  for (int r = 0; r < 16; ++r) p0[r] = __builtin_amdgcn_exp2f(p0[r]);
}
__device__ __forceinline__ void finishSM(f32x16& p0, f32x16& p1, float alpha, float& l_reg, bf16x8& pa0, bf16x8& pa1, bf16x8& pa2, bf16x8& pa3) {
#pragma unroll
  for (int r = 0; r < 16; ++r) p1[r] = __builtin_amdgcn_exp2f(p1[r]);
  float ps = 0;
#pragma unroll
  for (int r = 0; r < 16; ++r) ps += p0[r];
#pragma unroll
  for (int r = 0; r < 16; ++r) ps += p1[r];
  { auto rr = __builtin_amdgcn_permlane32_swap(__float_as_uint(ps), __float_as_uint(ps), false, false);
    ps = __uint_as_float(rr[0]) + __uint_as_float(rr[1]); }
  l_reg = l_reg * alpha + ps;
#define PK4(P, BASE, OUT) do { unsigned a0 = cvtpk(P[BASE + 0], P[BASE + 1]), a1 = cvtpk(P[BASE + 2], P[BASE + 3]);   \
    unsigned b0 = cvtpk(P[BASE + 4], P[BASE + 5]), b1 = cvtpk(P[BASE + 6], P[BASE + 7]);                              \
    auto r0 = __builtin_amdgcn_permlane32_swap(a0, b0, false, false); auto r1 = __builtin_amdgcn_permlane32_swap(a1, b1, false, false); \
    u32x4 w = {r0[0], r1[0], r0[1], r1[1]}; OUT = *reinterpret_cast<bf16x8*>(&w); } while (0)
  PK4(p0, 0, pa0); PK4(p0, 8, pa1); PK4(p1, 0, pa2); PK4(p1, 8, pa3);
#undef PK4
}
__device__ __forceinline__ void qkt(f32x16& p0, f32x16& p1, const char* Ks, const bf16x8* qr, int r32, int hi) {
  p0 = f32x16{}; p1 = f32x16{};
#pragma unroll
  for (int d0 = 0; d0 < 6; ++d0) { const int cb = (d0 * 16 + hi * 8) * 2;
    const bf16x8 b0 = *reinterpret_cast<const bf16x8*>(Ks + r32 * KROW + cb);
    const bf16x8 b1 = *reinterpret_cast<const bf16x8*>(Ks + (32 + r32) * KROW + cb);
    p0 = __builtin_amdgcn_mfma_f32_32x32x16_bf16(b0, qr[d0], p0, 0, 0, 0);
    p1 = __builtin_amdgcn_mfma_f32_32x32x16_bf16(b1, qr[d0], p1, 0, 0, 0); }
}
__device__ __forceinline__ int v_st(int k, int c) { const int kk = (k & ~0xC) | ((k & 4) << 1) | ((k & 8) >> 1); return ((kk >> 3) * 2 + (c >> 5)) * 512 + ((kk & 7) * 32 + (c & 31)) * 2; }
__device__ __forceinline__ int v_rd_base(int lane) { return ((lane & 3) << 3) | (((lane >> 2) & 3) << 6) | (((lane >> 4) & 1) << 5) | (((lane >> 5) & 1) << 8); }
constexpr int v_rd_off(int d0, int ks, int half) { return d0 * 512 + ks * 2048 + half * 1024; }
template <int OFF> __device__ __forceinline__ s16x4 tr_read(int vb) { s16x4 r; asm volatile("ds_read_b64_tr_b16 %0, %1 offset:%2" : "=&v"(r) : "v"(vb), "i"(OFF) : "memory"); return r; }
template <int D0> __device__ __forceinline__ void pv_one(f32x16& od, int vb, bf16x8 pa0, bf16x8 pa1, bf16x8 pa2, bf16x8 pa3) {
  const s16x4 l0 = tr_read<v_rd_off(D0, 0, 0)>(vb), h0 = tr_read<v_rd_off(D0, 0, 1)>(vb), l1 = tr_read<v_rd_off(D0, 1, 0)>(vb), h1 = tr_read<v_rd_off(D0, 1, 1)>(vb);
  const s16x4 l2 = tr_read<v_rd_off(D0, 2, 0)>(vb), h2 = tr_read<v_rd_off(D0, 2, 1)>(vb), l3 = tr_read<v_rd_off(D0, 3, 0)>(vb), h3 = tr_read<v_rd_off(D0, 3, 1)>(vb);
  asm volatile("s_waitcnt lgkmcnt(0)" ::: "memory"); SBAR();
#define PK(L, H) (bf16x8){L[0], L[1], L[2], L[3], H[0], H[1], H[2], H[3]}
  od = __builtin_amdgcn_mfma_f32_32x32x16_bf16(pa0, PK(l0, h0), od, 0, 0, 0);
  od = __builtin_amdgcn_mfma_f32_32x32x16_bf16(pa1, PK(l1, h1), od, 0, 0, 0);
  od = __builtin_amdgcn_mfma_f32_32x32x16_bf16(pa2, PK(l2, h2), od, 0, 0, 0);
  od = __builtin_amdgcn_mfma_f32_32x32x16_bf16(pa3, PK(l3, h3), od, 0, 0, 0);
#undef PK
}
__device__ __forceinline__ void pv_d0(f32x16* o, int vb, bf16x8 pa0, bf16x8 pa1, bf16x8 pa2, bf16x8 pa3) {
  pv_one<0>(o[0], vb, pa0, pa1, pa2, pa3); pv_one<1>(o[1], vb, pa0, pa1, pa2, pa3);
}
__device__ __forceinline__ void attn_unit(const unsigned short* __restrict__ Qb, const unsigned short* __restrict__ Kh, const unsigned short* __restrict__ Vh, unsigned short* __restrict__ Ob, int ldo, char* lds) {
  const int tid = tid_fresh(), wid = tid >> 6, lane = tid & 63, r32 = lane & 31, hi = lane >> 5;
  char* V_lds = lds + OFF_V; char* K_lds = lds + OFF_K;
  float* ws = (float*)(lds + OFF_WS) + wid * 64; float* li_l = ws; float* al_l = ws + 32;
  float m_reg = -1e30f, l_reg = 0; f32x16 o[2] = {}; bf16x8 qr[6];
  const unsigned short* Qw = Qb + (size_t)(wid * QBLK + r32) * DQK + hi * 8;
#pragma unroll
  for (int d0 = 0; d0 < 6; ++d0) qr[d0] = *reinterpret_cast<const bf16x8*>(Qw + d0 * 16);
  const bool k2 = wid < 4; const int c2 = k2 ? 512 + tid : tid;
  const int kst0 = (tid / 12) * KROW + (tid % 12) * 16, kst1 = (c2 / 12) * KROW + (c2 % 12) * 16, vst = v_st(tid >> 3, (tid & 7) * 8);
  const int vb0 = (int)(uintptr_t)V_lds + v_rd_base(lane);
  struct { bf16x8 k0, k1, v; } sr_[2];
#define SLOAD(i, key0) do { sr_[i].k0 = *reinterpret_cast<const bf16x8*>(Kh + (size_t)(key0) * DQK + tid * 8); sr_[i].k1 = *reinterpret_cast<const bf16x8*>(Kh + (size_t)(key0) * DQK + c2 * 8); \
    sr_[i].v = *reinterpret_cast<const bf16x8*>(Vh + (size_t)(key0) * DV + tid * 8); } while (0)
#define SWRITE(b, i) do { *(bf16x8*)(K_lds + (b) * SHM_K + kst0) = sr_[i].k0; if (k2) *(bf16x8*)(K_lds + (b) * SHM_K + kst1) = sr_[i].k1; *(bf16x8*)(V_lds + (b) * SHM_V + vst) = sr_[i].v; } while (0)
#define SWAIT() asm volatile("s_waitcnt vmcnt(3)" ::: "memory")
#define RESC(a) do { if (__any((a) < 1.f)) { if (hi == 0) al_l[r32] = (a); asm volatile("s_waitcnt lgkmcnt(0)" ::: "memory"); \
    _Pragma("unroll") for (int d = 0; d < 2; ++d) _Pragma("unroll") for (int r = 0; r < 16; ++r) o[d][r] *= al_l[crow(r, hi)]; } } while (0)
  f32x16 pA0, pA1, pB0, pB1; float alA, alB; bf16x8 pa0, pa1, pa2, pa3;
  SLOAD(0, 0); asm volatile("s_waitcnt vmcnt(0)" ::: "memory"); SWRITE(0, 0); __syncthreads();
  qkt(pA0, pA1, K_lds, qr, r32, hi); partialSM(pA0, pA1, m_reg, alA);
  SLOAD(1, KVBLK); SLOAD(0, 2 * KVBLK);
  SWAIT(); SWRITE(1, 1); __syncthreads();
  for (int j = 1; j + 1 < NT; j += 2) {
    SBAR(); qkt(pB0, pB1, K_lds + SHM_K, qr, r32, hi);
    finishSM(pA0, pA1, alA, l_reg, pa0, pa1, pa2, pa3); SBAR();
    SLOAD(1, (j + 2) * KVBLK); SBAR();
    pv_d0(o, vb0, pa0, pa1, pa2, pa3); partialSM(pB0, pB1, m_reg, alB);
    __syncthreads(); SWAIT(); SWRITE(0, 0);
    RESC(alB); __syncthreads();
    SBAR(); qkt(pA0, pA1, K_lds, qr, r32, hi);
    finishSM(pB0, pB1, alB, l_reg, pa0, pa1, pa2, pa3); SBAR();
    if (j + 3 < NT) SLOAD(0, (j + 3) * KVBLK); SBAR();
    pv_d0(o, vb0 + SHM_V, pa0, pa1, pa2, pa3); partialSM(pA0, pA1, m_reg, alA);
    __syncthreads(); SWAIT(); SWRITE(1, 1);
    RESC(alA); __syncthreads();
  }
  SBAR(); qkt(pB0, pB1, K_lds + SHM_K, qr, r32, hi);
  finishSM(pA0, pA1, alA, l_reg, pa0, pa1, pa2, pa3); SBAR();
  pv_d0(o, vb0, pa0, pa1, pa2, pa3); partialSM(pB0, pB1, m_reg, alB);
  __syncthreads(); RESC(alB);
  finishSM(pB0, pB1, alB, l_reg, pa0, pa1, pa2, pa3); SBAR();
  pv_d0(o, vb0 + SHM_V, pa0, pa1, pa2, pa3);
  if (hi == 0) li_l[r32] = l_reg; asm volatile("s_waitcnt lgkmcnt(0)" ::: "memory");
  float rli[16];
#pragma unroll
  for (int r = 0; r < 16; ++r) rli[r] = __builtin_amdgcn_rcpf(li_l[crow(r, hi)]);
  { unsigned short* stg = (unsigned short*)(lds + OFF_OST) + wid * 2048;
#pragma unroll
    for (int r = 0; r < 16; ++r) { const int orow = crow(r, hi);
#pragma unroll
      for (int d0 = 0; d0 < 2; ++d0) { const unsigned pk = cvtpk(o[d0][r] * rli[r], 0.f); stg[orow * 64 + d0 * 32 + r32] = (unsigned short)pk; } }
    asm volatile("s_waitcnt lgkmcnt(0)" ::: "memory");
    unsigned short* Ow = Ob + (size_t)(wid * QBLK) * ldo;
#pragma unroll
    for (int i = 0; i < 4; ++i) { const int row = i * 8 + (lane >> 3), ch = lane & 7; const u32x4 v = *(const u32x4*)(stg + row * 64 + ch * 8); *(u32x4*)(Ow + (size_t)row * ldo + ch * 8) = v; } }
  __syncthreads();
#undef SLOAD
#undef SWRITE
#undef SWAIT
#undef RESC
}
#undef SBAR
}

constexpr size_t al256(size_t x) { return (x + 255) / 256 * 256; }
constexpr size_t WS_CTL = 0, CTL_BYTES = 1u << 20;
constexpr size_t WS_MODS = WS_CTL + CTL_BYTES;
constexpr size_t WS_ROPE = WS_MODS + al256((size_t)9 * NMODV * 4);
constexpr size_t WS_KTAB = WS_ROPE + al256((size_t)SEQ * 16 * 2 * 4);
constexpr size_t WS_WGU1 = WS_KTAB + al256((size_t)SG * 2 * CH * 256 * 4);
constexpr size_t WS_WD1  = WS_WGU1 + al256((size_t)2 * DFF * DM * 2);
constexpr size_t WS_WGU2 = WS_WD1 + al256((size_t)DM * DFF * 2);
constexpr size_t WS_WD2  = WS_WGU2 + al256((size_t)2 * DFF * DM * 2);
constexpr size_t WS_WIN  = WS_WD2 + al256((size_t)DM * DFF * 2);
constexpr size_t WS_WUQ  = WS_WIN + al256((size_t)DINP * DM * 2);
constexpr size_t WS_WUKV = WS_WUQ + al256((size_t)1280 * 256 * 2);
constexpr size_t WS_WOUT = WS_WUKV + al256((size_t)1536 * 256 * 2);
constexpr size_t WS_WGLU = WS_WOUT + al256((size_t)DM * DM * 2);
constexpr size_t WS_BTY  = WS_WGLU + al256((size_t)512 * 256 * 2);
constexpr size_t WS_BTE  = WS_BTY + al256((size_t)SG * 1024 * AUK * 2);
constexpr size_t WS_AU   = WS_BTE + al256((size_t)SG * 256 * 1024 * 2);
constexpr size_t WS_E    = WS_AU + al256((size_t)SG * AUR * AUK * 2);
constexpr size_t WS_A    = WS_E + al256((size_t)SG * AUR * 256 * 4);
constexpr size_t WS_X1C  = WS_A + al256((size_t)MT * DM * 2);
constexpr size_t WS_CQ   = WS_X1C + al256((size_t)NCTX * DM * 4);
constexpr size_t WS_CKV  = WS_CQ + al256((size_t)NLAT * 256 * 2);
constexpr size_t WS_V    = WS_CKV + al256((size_t)MT * 256 * 2);
constexpr size_t WS_ZS   = WS_V + al256((size_t)NB * NH * SKV * DV * 2);
constexpr size_t WS_H    = WS_ZS + al256((size_t)NLAT * 256 * 2);
constexpr size_t WS_P    = WS_H;
constexpr size_t WS_Q    = WS_H;
constexpr size_t WS_K    = WS_P + al256((size_t)MT * DINP * 4);
constexpr size_t WS_END  = WS_H + al256((size_t)MT * DFF * 2);
static_assert(WS_K + (size_t)NB * NH * SKV * DQK * 2 <= WS_END && WS_P + (size_t)MT * DINP * 4 <= WS_END, "overlays fit in H");
static_assert(WS_END <= (size_t)512 * 1024 * 1024, "workspace map must fit 512 MiB");

#define LAS __attribute__((address_space(3)))
typedef unsigned short bf16;
typedef unsigned v4u __attribute__((ext_vector_type(4)));
typedef unsigned v2u __attribute__((ext_vector_type(2)));
typedef float f32x4 __attribute__((ext_vector_type(4)));
typedef float f32x2 __attribute__((ext_vector_type(2)));
#define LDS_WAIT() asm volatile("s_waitcnt lgkmcnt(0)" ::: "memory")
__device__ __forceinline__ unsigned f2bf(float f) { unsigned u = __builtin_bit_cast(unsigned, f); return (u + 0x7fffu + ((u >> 16) & 1u)) >> 16; }
__device__ __forceinline__ unsigned pk2(float lo, float hi) { return f2bf(lo) | (f2bf(hi) << 16); }
__device__ __forceinline__ float bf2f(unsigned short b) { return __builtin_bit_cast(float, (unsigned)b << 16); }
__device__ __forceinline__ float wave_sum(float v) {
#pragma unroll
    for (int o = 1; o < 64; o <<= 1) v += __shfl_xor(v, o);
    return v;
}

#define XB_TMO      128
#define XB_XCNT(j)  (256  + 64 * (j))
#define XB_XSUB(j)  (1280 + 64 * (j))
#define XB_XGEN(j)  (2304 + 64 * (j))
#define XB_TOP      3328
#define XB_TOPGEN   3392
#define XCD_BAR_WORDS 3456
#define XB_SPIN_CAP (1u << 22)
__device__ __forceinline__ unsigned xb_ld(unsigned* p)              { return __hip_atomic_load(p, __ATOMIC_RELAXED, __HIP_MEMORY_SCOPE_AGENT); }
__device__ __forceinline__ unsigned xb_add(unsigned* p, unsigned v) { return __hip_atomic_fetch_add(p, v, __ATOMIC_RELAXED, __HIP_MEMORY_SCOPE_AGENT); }
__device__ __forceinline__ unsigned xb_xcc_id() { return (unsigned)__builtin_amdgcn_s_getreg((3 << 11) | 20) & 0xFu; }
#define XB_SPIN(cond, bar) do { unsigned _sp = 0; while (cond) { __builtin_amdgcn_s_sleep(1); \
    if ((++_sp & 255u) == 0u) { if (xb_ld(&(bar)[XB_TMO])) break; if (_sp > XB_SPIN_CAP) { atomicAdd(&(bar)[XB_TMO], 1u); break; } } } } while (0)
struct XcdBarrier { unsigned* bar; unsigned x; volatile LAS unsigned* st; };
__device__ __forceinline__ XcdBarrier xcd_barrier_post(unsigned* bar, volatile LAS unsigned* st) {
    XcdBarrier b; b.bar = bar; b.x = xb_xcc_id(); b.st = st;
    if (threadIdx.x == 0) (void)xb_add(&bar[XB_XCNT(b.x)], 1u);
    return b;
}
__device__ __forceinline__ void xcd_barrier_complete(unsigned* bar, unsigned x, unsigned& nloc, unsigned& nx) {
    const unsigned G = gridDim.x * gridDim.y * gridDim.z;
    unsigned sum, cnt, mine, sp = 0u;
    for (;;) {
        sum = 0u; cnt = 0u; mine = 0u;
#pragma unroll
        for (unsigned j = 0; j < 16; ++j) { const unsigned c = xb_ld(&bar[XB_XCNT(j)]); sum += c; cnt += (c > 0u) ? 1u : 0u; mine = (j == x) ? c : mine; }
        if (sum == G) break;
        __builtin_amdgcn_s_sleep(1);
        if ((++sp & 255u) == 0u) { if (xb_ld(&bar[XB_TMO])) break; if (sp > XB_SPIN_CAP) { atomicAdd(&bar[XB_TMO], 1u); break; } }
    }
    nloc = mine > 0u ? mine : 1u; nx = cnt > 0u ? cnt : 1u;
}
__device__ __forceinline__ void xcd_barrier(const XcdBarrier& b) {
    asm volatile("s_waitcnt vmcnt(0)" ::: "memory");
    __syncthreads();
    if (threadIdx.x == 0) {
        unsigned* bar = b.bar;
        __builtin_amdgcn_s_waitcnt(0);
        unsigned nloc = b.st[0], nx = b.st[1];
        if (nloc == 0u) { xcd_barrier_complete(bar, b.x, nloc, nx); b.st[0] = nloc; b.st[1] = nx; }
        const unsigned old = xb_add(&bar[XB_XSUB(b.x)], 1u);
        const unsigned gen = old / nloc;
        if (old + 1u == (gen + 1u) * nloc) {
            __builtin_amdgcn_fence(__ATOMIC_RELEASE, "agent");
            asm volatile("s_waitcnt vmcnt(0)" ::: "memory");
            const unsigned og = xb_add(&bar[XB_TOP], 1u);
            const unsigned tg = og / nx;
            if (og + 1u == (tg + 1u) * nx) xb_add(&bar[XB_TOPGEN], 1u);
            else XB_SPIN(xb_ld(&bar[XB_TOPGEN]) == tg, bar);
            __builtin_amdgcn_fence(__ATOMIC_ACQUIRE, "agent");
            xb_add(&bar[XB_XGEN(b.x)], 1u);
            asm volatile("s_waitcnt vmcnt(0)" ::: "memory");
        } else {
            XB_SPIN(xb_ld(&bar[XB_XGEN(b.x)]) == gen, bar);
            __builtin_amdgcn_fence(__ATOMIC_ACQUIRE, "agent");
            asm volatile("s_waitcnt vmcnt(0)" ::: "memory");
        }
    }
    __syncthreads();
}

constexpr int NWAVES = 8, NTHREADS = 512, NPHASES = 17;
constexpr int RING_BYTES = 131072, LDSCTL_OFF = RING_BYTES, LDS_BYTES = 147456;
struct Args { const float* in[31]; float* out; unsigned char* ws; int ph_lo, ph_hi, use_bar, pad; };
enum { I_X = 0, I_C, I_CTX, I_CCTX, I_WMOD, I_BMOD, I_GFFN1, I_WGU1, I_WD1, I_GMIX, I_WIN, I_GCQ, I_WUQ, I_GCKV, I_WUKV, I_LAMRE, I_LAMIM, I_LOGDT, I_BRE, I_BIM, I_CRE, I_CIM,
       I_DSKIP, I_WGLU, I_GMLA, I_GSSM, I_WOUT, I_GFFN2, I_WGU2, I_WD2, I_GFINAL };

struct S5P { float lrdt, lidt_rev_hi; double lidt_rev; float fr, fi; };
__device__ __forceinline__ void s5_par(const float* lam_re, const float* lam_im, const float* log_dt, int d, int g, int p, float& lrdt, double& rev, float& fr, float& fi) {
    const float dt = __expf(log_dt[d * SG + g]); const float lr = fminf(lam_re[(d * SG + g) * SP + p], -1e-4f), li = lam_im[(d * SG + g) * SP + p];
    lrdt = lr * dt; rev = (double)li * (double)dt * 0.15915494309189535;
    double r1 = rev - __builtin_rint(rev); const float rf = (float)r1;
    const float mag = __expf(lrdt), ar = mag * __builtin_amdgcn_cosf(rf), ai = mag * __builtin_amdgcn_sinf(rf);
    const float den = lr * lr + li * li;
    fr = ((ar - 1.0f) * lr + ai * li) / den; fi = (ai * lr - (ar - 1.0f) * li) / den;
}
__device__ __forceinline__ void s5_apow(float lrdt, double rev, int e, float& wr, float& wi) {
    const float mag = __expf(lrdt * (float)e); double r = rev * (double)e; r -= __builtin_rint(r); const float rf = (float)r;
    wr = mag * __builtin_amdgcn_cosf(rf); wi = mag * __builtin_amdgcn_sinf(rf);
}

__device__ __forceinline__ void tr_item(const float* W, int N, int k0, int n0, bf16* WT, int ldt, int drow0, LAS float* scr, int lane) {
#pragma unroll 8
    for (int i = 0; i < 32; ++i) { const int kk = 2 * i + (lane >> 5); scr[kk * 33 + (lane & 31)] = W[(size_t)(k0 + kk) * N + n0 + (lane & 31)]; }
    LDS_WAIT(); asm volatile("" ::: "memory");
    const int c = lane & 7;
#pragma unroll
    for (int j = 0; j < 4; ++j) { const int n = (lane >> 3) + 8 * j; const LAS float* s = scr + (8 * c) * 33 + n;
        v4u o; o.x = pk2(s[0 * 33], s[1 * 33]); o.y = pk2(s[2 * 33], s[3 * 33]); o.z = pk2(s[4 * 33], s[5 * 33]); o.w = pk2(s[6 * 33], s[7 * 33]);
        *(v4u*)(WT + (size_t)(drow0 + n) * ldt + k0 + 8 * c) = o; }
    LDS_WAIT(); asm volatile("" ::: "memory");
}
__device__ __forceinline__ int glu_row(int n0, int Nh) { const int hh = n0 >= Nh ? 1 : 0, j = n0 - hh * Nh; return (j >> 7) * 256 + hh * 128 + (j & 127); }

typedef const __attribute__((address_space(4))) Args* ArgsP;
__device__ __forceinline__ ArgsP get_args() { ArgsP p = (ArgsP)__builtin_amdgcn_kernarg_segment_ptr(); asm volatile("" : "+s"(p)); return p; }
template <int ph> __device__ __forceinline__ void run_phase(unsigned char* lds_raw) {
    ArgsP ap = get_args();
    LAS unsigned char* lds = (LAS unsigned char*)lds_raw;
    const int tid = tid_fresh(), lane = tid & 63, wave = __builtin_amdgcn_readfirstlane(tid >> 6);
    const int G = gridDim.x, bx = blockIdx.x, vcu = (G % 8 == 0) ? (bx % 8) * (G / 8) + bx / 8 : bx;
    const int gw = vcu * NWAVES + wave, NGW = G * NWAVES;
    unsigned char* ws = ap->ws;
    float* MODS = (float*)(ws + WS_MODS); float* ROPE = (float*)(ws + WS_ROPE); float* KTAB = (float*)(ws + WS_KTAB);
    bf16* WGU1 = (bf16*)(ws + WS_WGU1); bf16* WD1 = (bf16*)(ws + WS_WD1); bf16* WGU2 = (bf16*)(ws + WS_WGU2); bf16* WD2 = (bf16*)(ws + WS_WD2);
    bf16* WIN = (bf16*)(ws + WS_WIN); bf16* WUQ = (bf16*)(ws + WS_WUQ); bf16* WUKV = (bf16*)(ws + WS_WUKV); bf16* WOUT = (bf16*)(ws + WS_WOUT); bf16* WGLU = (bf16*)(ws + WS_WGLU);
    bf16* BTY = (bf16*)(ws + WS_BTY); bf16* BTE = (bf16*)(ws + WS_BTE); bf16* AU = (bf16*)(ws + WS_AU); float* EB = (float*)(ws + WS_E);
    bf16* A = (bf16*)(ws + WS_A); float* X1C = (float*)(ws + WS_X1C); bf16* CQ = (bf16*)(ws + WS_CQ); bf16* CKV = (bf16*)(ws + WS_CKV);
    bf16* VF = (bf16*)(ws + WS_V); bf16* ZS = (bf16*)(ws + WS_ZS); bf16* H = (bf16*)(ws + WS_H); float* P = (float*)(ws + WS_P); bf16* QF = (bf16*)(ws + WS_Q); bf16* KF = (bf16*)(ws + WS_K);
    float* X1 = ap->out;

        if constexpr (ph == 0) {
            LAS float* fl = (LAS float*)lds;
            {
                LAS float* sil = fl;
                LAS float* red = fl + 9 * 1024;
                for (int i = tid; i < 9 * 1024; i += NTHREADS) { const int r = i >> 10, k = i & 1023; const float c = r < NB ? ap->in[I_C][r * DM + k] : ap->in[I_CCTX][k]; sil[i] = c * pg8::sigmoidf_fast(c); }
                __syncthreads();
                const int cgp = tid & 7, kg = tid >> 3;
                for (int item = bx; item < NMODV / 32; item += G) {
                    const int j0 = item * 32 + cgp * 4;
                    f32x4 acc[9];
#pragma unroll
                    for (int r = 0; r < 9; ++r) acc[r] = (f32x4){0.f, 0.f, 0.f, 0.f};
#pragma unroll 4
                    for (int kk = 0; kk < 16; ++kk) { const int k = kg * 16 + kk; const f32x4 w = *(const f32x4*)(ap->in[I_WMOD] + (size_t)k * NMODV + j0);
#pragma unroll
                        for (int r = 0; r < 9; ++r) acc[r] += w * sil[r * 1024 + k]; }
#pragma unroll
                    for (int r = 0; r < 9; ++r) *(LAS f32x4*)(red + (kg * 9 + r) * 32 + cgp * 4) = acc[r];
                    __syncthreads();
                    if (tid < 9 * 32) { const int r = tid >> 5, c = tid & 31; float s = 0.f;
                        for (int q = 0; q < 64; ++q) s += red[(q * 9 + r) * 32 + c];
                        MODS[(size_t)r * NMODV + item * 32 + c] = s + ap->in[I_BMOD][item * 32 + c]; }
                    __syncthreads();
                }
            }
            {
                LAS float* Cr = fl; LAS float* Ci = fl + 1024; LAS float* Br = fl + 2048; LAS float* Bi = fl + 3072; LAS float* Wr = fl + 4096; LAS float* Wi = fl + 4160;
                for (int item = bx; item < 2 * SG * 8; item += G) {
                    const int d = item >> 7, g = (item >> 3) & 15, oct = item & 7;
                    __syncthreads();
                    for (int i = tid; i < 1024; i += NTHREADS) {
                        Cr[i] = ap->in[I_CRE][(size_t)(d * SG + g) * 1024 + i]; Ci[i] = ap->in[I_CIM][(size_t)(d * SG + g) * 1024 + i];
                        const int p = i >> 4; float lrdt, fr, fi; double rev; s5_par(ap->in[I_LAMRE], ap->in[I_LAMIM], ap->in[I_LOGDT], d, g, p, lrdt, rev, fr, fi);
                        const float br = ap->in[I_BRE][(size_t)(d * SG + g) * 1024 + i], bi = ap->in[I_BIM][(size_t)(d * SG + g) * 1024 + i];
                        Br[i] = fr * br - fi * bi; Bi[i] = fr * bi + fi * br; }
                    for (int tt = 0; tt < 8; ++tt) { const int tau = oct * 8 + tt;
                        __syncthreads();
                        if (tid < SP) { float lrdt, fr, fi; double rev; s5_par(ap->in[I_LAMRE], ap->in[I_LAMIM], ap->in[I_LOGDT], d, g, tid, lrdt, rev, fr, fi); float wr, wi; s5_apow(lrdt, rev, tau, wr, wi); Wr[tid] = wr; Wi[tid] = wi; }
                        __syncthreads();
                        if (tid < 256) { const int co = tid >> 4, ci = tid & 15; float s = 0.f;
                            for (int p = 0; p < SP; ++p) { const float cr = Cr[co * 64 + p], cim = Ci[co * 64 + p], wr = Wr[p], wi = Wi[p];
                                const float cwr = cr * wr - cim * wi, cwi = cr * wi + cim * wr; s += cwr * Br[p * 16 + ci] - cwi * Bi[p * 16 + ci]; }
                            KTAB[((size_t)(g * 2 + d) * CH + tau) * 256 + tid] = s; }
                    }
                }
                __syncthreads();
            }
            LAS float* scr = (LAS float*)(lds + wave * 16384);
            {
                const int I1 = (DM / 64) * (2 * DFF / 32), I2 = (DFF / 64) * (DM / 32), I3 = (DM / 64) * (672 / 32), I4 = (256 / 64) * (1152 / 32), I5 = (128 / 64) * (1536 / 32), I6 = (DM / 64) * (DM / 32), I7 = (256 / 64) * (512 / 32);
                const int NIT = 2 * I1 + 2 * I2 + I3 + I4 + I5 + I6 + I7;
                for (int it = gw; it < NIT; it += NGW) {
                    int r = it;
                    if (r < 2 * I1) { const int which = r >= I1; r -= which * I1; const int nblk = 2 * DFF / 32, kb = r / nblk, nb = r % nblk;
                        tr_item(ap->in[which ? I_WGU2 : I_WGU1], 2 * DFF, kb * 64, nb * 32, which ? WGU2 : WGU1, DM, glu_row(nb * 32, DFF) - 0, scr, lane); continue; } r -= 2 * I1;
                    if (r < 2 * I2) { const int which = r >= I2; r -= which * I2; const int nblk = DM / 32, kb = r / nblk, nb = r % nblk;
                        tr_item(ap->in[which ? I_WD2 : I_WD1], DM, kb * 64, nb * 32, which ? WD2 : WD1, DFF, nb * 32, scr, lane); continue; } r -= 2 * I2;
                    if (r < I3) { const int nblk = 672 / 32, kb = r / nblk, nb = r % nblk; tr_item(ap->in[I_WIN], 672, kb * 64, nb * 32, WIN, DM, nb * 32, scr, lane); continue; } r -= I3;
                    if (r < I4) { const int nblk = 1152 / 32, kb = r / nblk, nb = r % nblk; tr_item(ap->in[I_WUQ], 1152, kb * 64, nb * 32, WUQ, 256, nb * 32, scr, lane); continue; } r -= I4;
                    if (r < I5) { const int nblk = 1536 / 32, kb = r / nblk, nb = r % nblk; tr_item(ap->in[I_WUKV], 1536, kb * 64, nb * 32, WUKV, 256, nb * 32, scr, lane); continue; } r -= I5;
                    if (r < I6) { const int nblk = DM / 32, kb = r / nblk, nb = r % nblk; tr_item(ap->in[I_WOUT], DM, kb * 64, nb * 32, WOUT, DM, nb * 32, scr, lane); continue; } r -= I6;
                    { const int nblk = 512 / 32, kb = r / nblk, nb = r % nblk; tr_item(ap->in[I_WGLU], 512, kb * 64, nb * 32, WGLU, 256, glu_row(nb * 32, 256), scr, lane); }
                }
            }
            { const v4u z = {0u, 0u, 0u, 0u}; const int gt = vcu * NTHREADS + tid, NGT = G * NTHREADS;
              for (int i = gt; i < 96 * DM / 8; i += NGT) *(v4u*)(WIN + (size_t)672 * DM + (size_t)i * 8) = z;
              for (int i = gt; i < 128 * 256 / 8; i += NGT) *(v4u*)(WUQ + (size_t)1152 * 256 + (size_t)i * 8) = z;
              for (int i = gt; i < 1536 * 16; i += NGT) *(v4u*)(WUKV + (size_t)(i >> 4) * 256 + 128 + (i & 15) * 8) = z;
              for (int i = gt; i < SEQ * 16; i += NGT) { const int t = i >> 4, ii = i & 15; const float pos = (float)(ii < 8 ? (t >> 6) : (t & 63));
                  const float invf = exp2f(-(float)(ii & 7) * (13.287712379549449f / 8.0f)); const float ang = pos * invf;
                  double rv = (double)ang * 0.15915494309189535; rv -= __builtin_rint(rv); const float rf = (float)rv;
                  *(f32x2*)(ROPE + (size_t)i * 2) = (f32x2){__builtin_amdgcn_cosf(rf), __builtin_amdgcn_sinf(rf)}; }
            }
            for (int it = gw; it < SG * 2 * CH; it += NGW) { const int g = it >> 7, d = (it >> 6) & 1, t = it & 63, p = lane;
                float lrdt, fr, fi; double rev; s5_par(ap->in[I_LAMRE], ap->in[I_LAMIM], ap->in[I_LOGDT], d, g, p, lrdt, rev, fr, fi);
                float wr, wi; s5_apow(lrdt, rev, d == 0 ? t + 1 : CH - t, wr, wi);
#pragma unroll 4
                for (int co = 0; co < SC; ++co) { const float cr = ap->in[I_CRE][((size_t)(d * SG + g) * SC + co) * SP + p], cim = ap->in[I_CIM][((size_t)(d * SG + g) * SC + co) * SP + p];
                    const float re = cr * wr - cim * wi, im = cr * wi + cim * wr;
                    *(unsigned*)(BTY + ((size_t)g * 1024 + t * 16 + co) * AUK + 1024 + d * 128 + 2 * p) = pk2(re, -im); } }
            for (int it = gw; it < SG * 2 * SP; it += NGW) { const int g = it >> 7, d = (it >> 6) & 1, p = it & 63, s = lane;
                float lrdt, fr, fi; double rev; s5_par(ap->in[I_LAMRE], ap->in[I_LAMIM], ap->in[I_LOGDT], d, g, p, lrdt, rev, fr, fi);
                float wr, wi; s5_apow(lrdt, rev, d == 0 ? CH - 1 - s : s, wr, wi);
                float ore[16], oim[16];
#pragma unroll
                for (int ci = 0; ci < SC; ++ci) { const float br = ap->in[I_BRE][((size_t)(d * SG + g) * SP + p) * SC + ci], bi = ap->in[I_BIM][((size_t)(d * SG + g) * SP + p) * SC + ci];
                    const float bbr = fr * br - fi * bi, bbi = fr * bi + fi * br; ore[ci] = wr * bbr - wi * bbi; oim[ci] = wr * bbi + wi * bbr; }
                bf16* r0 = BTE + ((size_t)g * 256 + d * 128 + 2 * p) * 1024 + s * 16; bf16* r1 = r0 + 1024;
                v4u a, b2; a.x = pk2(ore[0], ore[1]); a.y = pk2(ore[2], ore[3]); a.z = pk2(ore[4], ore[5]); a.w = pk2(ore[6], ore[7]); b2.x = pk2(ore[8], ore[9]); b2.y = pk2(ore[10], ore[11]); b2.z = pk2(ore[12], ore[13]); b2.w = pk2(ore[14], ore[15]);
                *(v4u*)r0 = a; *(v4u*)(r0 + 8) = b2;
                a.x = pk2(oim[0], oim[1]); a.y = pk2(oim[2], oim[3]); a.z = pk2(oim[4], oim[5]); a.w = pk2(oim[6], oim[7]); b2.x = pk2(oim[8], oim[9]); b2.y = pk2(oim[10], oim[11]); b2.z = pk2(oim[12], oim[13]); b2.w = pk2(oim[14], oim[15]);
                *(v4u*)r1 = a; *(v4u*)(r1 + 8) = b2; }
        }
        if constexpr (ph == 1 || ph == 4 || ph == 13) {
            const int gi = ph == 1 ? I_GFFN1 : ph == 4 ? I_GMIX : I_GFFN2, msh = ph == 1 ? 0 : ph == 4 ? 3 : 6;
            const float* gvec = ap->in[gi];
            const int nrows = ph == 13 ? NLAT : MT;
            for (int r = gw; r < nrows; r += NGW) {
                const bool isc = r >= NLAT; const int mrow = isc ? NB : (r >> 12);
                const float* src = ph == 1 ? (isc ? ap->in[I_CTX] + (size_t)(r - NLAT) * DM : ap->in[I_X] + (size_t)r * DM) : (isc ? X1C + (size_t)(r - NLAT) * DM : X1 + (size_t)r * DM);
                const float* shift = MODS + (size_t)mrow * NMODV + msh * DM; const float* scale = shift + DM;
                f32x4 v[4]; float s = 0.f;
#pragma unroll
                for (int j = 0; j < 4; ++j) { v[j] = *(const f32x4*)(src + 4 * lane + 256 * j); s += (v[j].x * v[j].x + v[j].y * v[j].y) + (v[j].z * v[j].z + v[j].w * v[j].w); }
                const float rinv = 1.0f / sqrtf(wave_sum(s) * (1.0f / DM) + EPS);
#pragma unroll
                for (int j = 0; j < 4; ++j) { const int c = 4 * lane + 256 * j; const f32x4 gg = *(const f32x4*)(gvec + c), sc = *(const f32x4*)(scale + c), sh = *(const f32x4*)(shift + c);
                    const f32x4 y = v[j] * rinv * gg * (sc + 1.0f) + sh; v2u o; o.x = pk2(y.x, y.y); o.y = pk2(y.z, y.w); *(v2u*)(A + (size_t)r * DM + c) = o; }
            }
            if (ph == 1) {
                for (int it = gw; it < SG * CH * SC; it += NGW) { const int g = it >> 10, t = (it >> 4) & 63, co = it & 15, s = lane;
                    float v[16];
#pragma unroll
                    for (int ci = 0; ci < 16; ++ci) v[ci] = 0.f;
                    if (s <= t) { const float* k0 = KTAB + ((size_t)(g * 2 + 0) * CH + (t - s)) * 256 + co * 16;
#pragma unroll
                        for (int q = 0; q < 4; ++q) { const f32x4 x = *(const f32x4*)(k0 + 4 * q); v[4 * q] += x.x; v[4 * q + 1] += x.y; v[4 * q + 2] += x.z; v[4 * q + 3] += x.w; } }
                    if (s >= t) { const float* k1 = KTAB + ((size_t)(g * 2 + 1) * CH + (s - t)) * 256 + co * 16;
#pragma unroll
                        for (int q = 0; q < 4; ++q) { const f32x4 x = *(const f32x4*)(k1 + 4 * q); v[4 * q] += x.x; v[4 * q + 1] += x.y; v[4 * q + 2] += x.z; v[4 * q + 3] += x.w; } }
                    if (s == t) { const float dsk = ap->in[I_DSKIP][g * 16 + co];
#pragma unroll
                        for (int ci = 0; ci < 16; ++ci) v[ci] += (ci == co) ? dsk : 0.f; }
                    bf16* dst = BTY + ((size_t)g * 1024 + t * 16 + co) * AUK + s * 16;
                    v4u a, b2; a.x = pk2(v[0], v[1]); a.y = pk2(v[2], v[3]); a.z = pk2(v[4], v[5]); a.w = pk2(v[6], v[7]); b2.x = pk2(v[8], v[9]); b2.y = pk2(v[10], v[11]); b2.z = pk2(v[12], v[13]); b2.w = pk2(v[14], v[15]);
                    *(v4u*)dst = a; *(v4u*)(dst + 8) = b2; }
            }
        }
        if constexpr (ph == 2 || ph == 14) {
            const int M = ph == 2 ? MT : NLAT;
            pg8::Gemm g{A, ph == 2 ? WGU1 : WGU2, DM, DM, DM}; pg8::StaticOrder S; S.init(M, 2 * DFF, G, bx);
            pg8::EpiSwiGLU E{H, DFF};
            pg8::gemm_phase<pg8::EpiSwiGLU, pg8::StaticOrder, true>(lds, g, S, E);
        }
        if constexpr (ph == 3 || ph == 12 || ph == 15) {
            const int M = ph == 3 ? MT : NLAT;
            pg8::Gemm g{ph == 12 ? A : H, ph == 3 ? WD1 : ph == 12 ? WOUT : WD2, ph == 12 ? DM : DFF, ph == 12 ? DM : DFF, ph == 12 ? DM : DFF};
            pg8::StaticOrder S; S.init(M, DM, G, bx);
            pg8::EpiResid E{ph == 3 ? ap->in[I_X] : X1, X1, ap->in[I_CTX], X1C, MODS + (ph == 3 ? 2 : ph == 12 ? 5 : 8) * DM, ph == 12 ? 1.0f : 0.5f};
            pg8::gemm_phase<pg8::EpiResid, pg8::StaticOrder, true>(lds, g, S, E);
        }
        if constexpr (ph == 5) {
            pg8::Gemm g{A, WIN, DM, DM, DM}; pg8::StaticOrder S; S.init(MT, DINP, G, bx);
            pg8::EpiF32 E{P, DINP, 0};
            pg8::gemm_phase<pg8::EpiF32, pg8::StaticOrder, true>(lds, g, S, E);
        }
        if constexpr (ph == 6) {
            for (int r = gw; r < MT; r += NGW) {
                const float* pr = P + (size_t)r * DINP; const bool isc = r >= NLAT;
                int b, t, key; if (isc) { const int q = r - NLAT; b = q >> 8; t = q & 255; key = t; } else { b = r >> 12; t = r & (SEQ - 1); key = CTXL + t; }
                if (!isc) { const f32x4 v = *(const f32x4*)(pr + 4 * lane); const float s = wave_sum((v.x * v.x + v.y * v.y) + (v.z * v.z + v.w * v.w));
                    const float rinv = 1.0f / sqrtf(s * (1.0f / 256.0f) + EPS); const f32x4 gq = *(const f32x4*)(ap->in[I_GCQ] + 4 * lane); const f32x4 y = v * rinv * gq;
                    v2u o; o.x = pk2(y.x, y.y); o.y = pk2(y.z, y.w); *(v2u*)(CQ + (size_t)r * 256 + 4 * lane) = o; }
                { const f32x2 v = *(const f32x2*)(pr + 256 + 2 * lane); const float s = wave_sum(v.x * v.x + v.y * v.y); const float rinv = 1.0f / sqrtf(s * (1.0f / 128.0f) + EPS);
                  const f32x2 gk = *(const f32x2*)(ap->in[I_GCKV] + 2 * lane); *(unsigned*)(CKV + (size_t)r * 256 + 2 * lane) = pk2(v.x * rinv * gk.x, v.y * rinv * gk.y);
                  *(unsigned*)(CKV + (size_t)r * 256 + 128 + 2 * lane) = 0u; }
                { const int i = lane & 15; const f32x2 v = *(const f32x2*)(pr + 384 + 2 * i); float o1 = v.x, o2 = v.y;
                  if (!isc) { const f32x2 cs = *(const f32x2*)(ROPE + ((size_t)t * 16 + i) * 2); o1 = v.x * cs.x - v.y * cs.y; o2 = v.x * cs.y + v.y * cs.x; }
                  const unsigned w = pk2(o1, o2);
#pragma unroll
                  for (int j = 0; j < 3; ++j) { const int h = (lane >> 4) + 4 * j; *(unsigned*)(KF + ((size_t)(b * NH + h) * SKV + key) * DQK + 64 + 2 * i) = w; } }
                { const f32x4 v = *(const f32x4*)(pr + 416 + 4 * lane); const int g = lane >> 2, ci0 = (lane & 3) * 4;
                  const int rowl = isc ? 512 + b * 4 + (t >> 6) : b * 64 + (t >> 6); const int s = t & 63;
                  v2u o; o.x = pk2(v.x, v.y); o.y = pk2(v.z, v.w); *(v2u*)(AU + ((size_t)g * AUR + rowl) * AUK + s * 16 + ci0) = o; }
            }
        }
        if constexpr (ph == 7) {
            { pg8::Gemm g{CQ, WUQ, 256, 256, 256}; pg8::StaticOrder S; S.init(NLAT, 1280, G, bx); pg8::EpiQ E{QF, ROPE};
              pg8::gemm_phase<pg8::EpiQ, pg8::StaticOrder, true>(lds, g, S, E); }
            { pg8::Gemm g{CKV, WUKV, 256, 256, 256}; pg8::StaticOrder S; S.init(MT, 1536, G, bx); pg8::EpiKV E{KF, VF};
              pg8::gemm_phase<pg8::EpiKV, pg8::StaticOrder, true>(lds, g, S, E); }
            { pg8::Gemm g{AU, BTE, 1024, AUK, 1024}; pg8::OrderE S{G, bx}; pg8::EpiF32 E{EB, 256, 1};
              pg8::gemm_phase<pg8::EpiF32, pg8::OrderE, true>(lds, g, S, E); }
        }
        if constexpr (ph == 8) {
            { const int ci = vcu * NTHREADS + tid;
              if (ci < NB * SG * 2 * SP) { const int p = ci & 63, d = (ci >> 6) & 1, g = (ci >> 7) & 15, b = ci >> 11;
                float lrdt, fr, fi; double rev; s5_par(ap->in[I_LAMRE], ap->in[I_LAMIM], ap->in[I_LOGDT], d, g, p, lrdt, rev, fr, fi);
                float ar, ai; s5_apow(lrdt, rev, CH, ar, ai);
                const float* Eg = EB + (size_t)g * AUR * 256 + d * 128 + 2 * p; bf16* Xg = AU + (size_t)g * AUR * AUK + 1024 + d * 128 + 2 * p;
                float xr = 0.f, xi = 0.f;
                for (int kc = 0; kc < 4; ++kc) { const int c = d == 0 ? kc : 3 - kc; const f32x2 e = *(const f32x2*)(Eg + (size_t)(512 + b * 4 + c) * 256);
                    const float nr = ar * xr - ai * xi + e.x, ni = ar * xi + ai * xr + e.y; xr = nr; xi = ni; }
#pragma unroll 8
                for (int k = 0; k < 64; ++k) { const int c = d == 0 ? k : 63 - k; const f32x2 e = *(const f32x2*)(Eg + (size_t)(b * 64 + c) * 256);
                    *(unsigned*)(Xg + (size_t)(b * 64 + c) * AUK) = pk2(xr, xi);
                    const float nr = ar * xr - ai * xi + e.x, ni = ar * xi + ai * xr + e.y; xr = nr; xi = ni; }
              } }
            for (int i = 0; ; ++i) { const int u = i * G + vcu; if (u >= NB * NH * (SEQ / 256)) break; const int bh = u >> 4, qb = u & 15, b = bh / NH, h = bh - b * NH;
                att::attn_unit(QF + ((size_t)bh * SEQ + qb * 256) * DQK, KF + (size_t)bh * SKV * DQK, VF + (size_t)bh * SKV * DV, A + ((size_t)b * SEQ + qb * 256) * DM + h * DV, DM, (char*)lds_raw); }
        }
        if constexpr (ph == 9) {
            pg8::Gemm g{AU, BTY, AUK, AUK, AUK}; pg8::OrderY S{G, bx}; pg8::EpiY E{ZS};
            pg8::gemm_phase<pg8::EpiY, pg8::OrderY, true>(lds, g, S, E);
        }
        if constexpr (ph == 10) {
            pg8::Gemm g{ZS, WGLU, 256, 256, 256}; pg8::StaticOrder S; S.init(NLAT, 512, G, bx); pg8::EpiGLU E{A, DM, 768};
            pg8::gemm_phase<pg8::EpiGLU, pg8::StaticOrder, true>(lds, g, S, E);
        }
        if constexpr (ph == 11) {
            for (int r = gw; r < NLAT; r += NGW) {
                bf16* row = A + (size_t)r * DM + 16 * lane; v4u w0 = *(const v4u*)row, w1 = *(const v4u*)(row + 8);
                float x[16]; const unsigned ww[8] = {w0.x, w0.y, w0.z, w0.w, w1.x, w1.y, w1.z, w1.w};
#pragma unroll
                for (int q = 0; q < 8; ++q) { x[2 * q] = __builtin_bit_cast(float, ww[q] << 16); x[2 * q + 1] = __builtin_bit_cast(float, ww[q] & 0xffff0000u); }
                float s = 0.f;
#pragma unroll
                for (int q = 0; q < 16; ++q) s += x[q] * x[q];
                const bool isa = lane < 48; const float sa = wave_sum(isa ? s : 0.f), ss = wave_sum(isa ? 0.f : s);
                const float rinv = isa ? 1.0f / sqrtf(sa * (1.0f / 768.0f) + EPS) : 1.0f / sqrtf(ss * (1.0f / 256.0f) + EPS);
                const float* gp = isa ? ap->in[I_GMLA] + 16 * lane : ap->in[I_GSSM] + 16 * (lane - 48);
                unsigned o[8];
#pragma unroll
                for (int q = 0; q < 4; ++q) { const f32x4 gg = *(const f32x4*)(gp + 4 * q); o[2 * q] = pk2(x[4 * q] * rinv * gg.x, x[4 * q + 1] * rinv * gg.y); o[2 * q + 1] = pk2(x[4 * q + 2] * rinv * gg.z, x[4 * q + 3] * rinv * gg.w); }
                *(v4u*)row = (v4u){o[0], o[1], o[2], o[3]}; *(v4u*)(row + 8) = (v4u){o[4], o[5], o[6], o[7]};
            }
        }
        if constexpr (ph == 16) {
            const float* gvec = ap->in[I_GFINAL];
            for (int r = gw; r < NLAT; r += NGW) {
                float* src = X1 + (size_t)r * DM; f32x4 v[4]; float s = 0.f;
#pragma unroll
                for (int j = 0; j < 4; ++j) { v[j] = *(const f32x4*)(src + 4 * lane + 256 * j); s += (v[j].x * v[j].x + v[j].y * v[j].y) + (v[j].z * v[j].z + v[j].w * v[j].w); }
                const float rinv = 1.0f / sqrtf(wave_sum(s) * (1.0f / DM) + EPS);
#pragma unroll
                for (int j = 0; j < 4; ++j) { const int c = 4 * lane + 256 * j; const f32x4 gg = *(const f32x4*)(gvec + c); *(f32x4*)(src + c) = v[j] * rinv * gg; }
            }
        }
}


template <int ph> __global__ void __launch_bounds__(NTHREADS, 2) fwd_ph(Args args) {
    extern __shared__ __attribute__((aligned(16))) unsigned char lds_raw[];
    run_phase<ph>(lds_raw);
}
#if MK_ONE_LAUNCH
__global__ void __launch_bounds__(NTHREADS, 2) fwd_all(Args args) {
    extern __shared__ __attribute__((aligned(16))) unsigned char lds_raw[];
    LAS unsigned char* lds = (LAS unsigned char*)lds_raw;
    const int tid = threadIdx.x;
    for (int u = tid; u < (LDS_BYTES - LDSCTL_OFF) / 4; u += NTHREADS) ((LAS unsigned*)(lds + LDSCTL_OFF))[u] = 0u;
    __syncthreads();
    XcdBarrier bar = xcd_barrier_post((unsigned*)(get_args()->ws + WS_CTL) + 4096, (volatile LAS unsigned*)(lds + LDSCTL_OFF + 64));
    run_phase<0>(lds_raw); cg::this_grid().sync();
    run_phase<1>(lds_raw); xcd_barrier(bar);
    run_phase<2>(lds_raw); xcd_barrier(bar);
    run_phase<3>(lds_raw); xcd_barrier(bar);
    run_phase<4>(lds_raw); xcd_barrier(bar);
    run_phase<5>(lds_raw); xcd_barrier(bar);
    run_phase<6>(lds_raw); xcd_barrier(bar);
    run_phase<7>(lds_raw); xcd_barrier(bar);
    run_phase<8>(lds_raw); xcd_barrier(bar);
    run_phase<9>(lds_raw); xcd_barrier(bar);
    run_phase<10>(lds_raw); xcd_barrier(bar);
    run_phase<11>(lds_raw); xcd_barrier(bar);
    run_phase<12>(lds_raw); xcd_barrier(bar);
    run_phase<13>(lds_raw); xcd_barrier(bar);
    run_phase<14>(lds_raw); xcd_barrier(bar);
    run_phase<15>(lds_raw); xcd_barrier(bar);
    run_phase<16>(lds_raw);
}
#endif

#include <utility>
#if MK_ONE_LAUNCH
#define KFUNC ((const void*)fwd_all)
static bool set_lds_attr() { return hipFuncSetAttribute((const void*)fwd_all, hipFuncAttributeMaxDynamicSharedMemorySize, LDS_BYTES) == hipSuccess; }
#else
#define KFUNC ((const void*)fwd_ph<2>)
template <int... P> static bool set_lds_attr_seq(std::integer_sequence<int, P...>) { bool ok = true; ((ok = ok && hipFuncSetAttribute((const void*)fwd_ph<P>, hipFuncAttributeMaxDynamicSharedMemorySize, LDS_BYTES) == hipSuccess), ...); return ok; }
static bool set_lds_attr() { return set_lds_attr_seq(std::make_integer_sequence<int, NPHASES>{}); }
template <int P> static void launch_one(const Args& a, int grid, hipStream_t stream) { fwd_ph<P><<<dim3(grid), dim3(NTHREADS), LDS_BYTES, stream>>>(a); }
template <int... P> static void launch_all_phases(const Args& a, int grid, hipStream_t stream, std::integer_sequence<int, P...>) { (launch_one<P>(a, grid, stream), ...); }
#endif
extern "C" void kernel_launch(void* const* d_in, const int* in_sizes, int n_in, void* d_out, int out_size, void* d_ws, size_t ws_size, hipStream_t stream) {
    static int grid = 0;
    if (grid == 0) {
        if (n_in != 31 || out_size != NLAT * DM || ws_size < WS_END) { fprintf(stderr, "kernel_launch: unexpected shapes n_in %d out %d ws %zu (need %zu)\n", n_in, out_size, ws_size, (size_t)WS_END); grid = -1; return; }
        int dev = 0, cus = 0, per_cu = 0;
        if (hipGetDevice(&dev) != hipSuccess || hipDeviceGetAttribute(&cus, hipDeviceAttributeMultiprocessorCount, dev) != hipSuccess) { grid = -1; return; }
        if (!set_lds_attr()) { fprintf(stderr, "kernel_launch: hipFuncSetAttribute failed\n"); grid = -1; return; }
        if (hipOccupancyMaxActiveBlocksPerMultiprocessor(&per_cu, KFUNC, NTHREADS, LDS_BYTES) != hipSuccess || per_cu < 1) { fprintf(stderr, "kernel_launch: occupancy query says %d\n", per_cu); per_cu = 1; }
        (void)hipGetLastError();
        grid = cus;
    }
    if (grid < 0) return;
    (void)hipMemsetAsync((char*)d_ws + WS_CTL, 0, CTL_BYTES, stream);
    Args a{};
    for (int i = 0; i < 31; ++i) a.in[i] = (const float*)d_in[i];
    a.out = (float*)d_out; a.ws = (unsigned char*)d_ws;
#if MK_ONE_LAUNCH
    a.ph_lo = 0; a.ph_hi = NPHASES; a.use_bar = 1;
    void* kargs[] = {&a};
    hipError_t e = hipLaunchCooperativeKernel((const void*)fwd_all, dim3(grid), dim3(NTHREADS), kargs, LDS_BYTES, stream);
    if (e != hipSuccess) fprintf(stderr, "kernel_launch: cooperative launch failed: %s (grid %d)\n", hipGetErrorString(e), grid);
#else
    a.ph_lo = 0; a.ph_hi = 1; a.use_bar = 0;
    launch_all_phases(a, grid, stream, std::make_integer_sequence<int, NPHASES>{});
    const hipError_t le = hipPeekAtLastError();
    if (le != hipSuccess) fprintf(stderr, "kernel_launch: launch failed: %s\n", hipGetErrorName(le));
#endif
}
```

```cpp
#include <hip/hip_runtime.h>
#include <hip/hip_cooperative_groups.h>
#include <cstdio>
#include <cstdint>
namespace cg = cooperative_groups;

#ifndef MK_ONE_LAUNCH
#define MK_ONE_LAUNCH 1
#endif
#ifndef PROBE_DUP
#define PROBE_DUP -1
#endif

constexpr int DM = 1024, NB = 8, SEQ = 4096, CTXL = 256, NLAT = NB * SEQ, NCTX = NB * CTXL, MT = NLAT + NCTX;
constexpr int DFF = 2816, NMODV = 9 * DM;
constexpr int NH = 12, DQK = 96, DV = 64, SKV = CTXL + SEQ;
constexpr int DINP = 768;
constexpr float EPS = 1e-6f;
constexpr float QSCALE = 0.10206207261596577f * 1.4426950408889634f;
constexpr int SG = 16, SC = 16, SP = 64, CH = 64;
constexpr int AUR = 768, AUK = 1280;

__device__ __forceinline__ int tid_fresh() { int t = threadIdx.x; asm volatile("" : "+v"(t)); return t; }
namespace pg8 {
#define PG8_LAS __attribute__((address_space(3)))
typedef unsigned short bf16_t;
typedef short bf16x8 __attribute__((ext_vector_type(8)));
typedef float f32x4 __attribute__((ext_vector_type(4)));
typedef float f32x2 __attribute__((ext_vector_type(2)));
typedef unsigned u32x4 __attribute__((ext_vector_type(4)));
constexpr int BM = 256, BK = 64, HALF = 128, HTB = HALF * BK * 2, STAGE_BYTES = 8 * HTB, NXCD = 8, WGM = 8;
__host__ __device__ __forceinline__ int lds_byte(int r, int c) { const int st = (r >> 4) * 2 + (c >> 5), rr = r & 15, cc = c & 31, ob = rr * 64 + cc * 2; return st * 1024 + (ob ^ (((ob >> 9) & 1) << 5)); }
__host__ __device__ __forceinline__ void stage_rc(int b, int& R, int& C) { const int st = b / 1024, sb = b % 1024, swz = sb ^ (((sb >> 9) & 1) << 5); R = (st >> 1) * 16 + swz / 64; C = (st & 1) * 32 + (swz % 64) / 2; }
__host__ __device__ __forceinline__ int perm32(int rho) { const int n = rho >> 4, i = rho & 15; return 8 * (i >> 2) + 4 * n + (i & 3); }
struct Unit { int pm, pn; };
struct Gemm { const bf16_t* A; const bf16_t* Bt; int K, lda, ldb; };
struct StaticOrder {
    int nM, nN, nwg, G, c;
    __device__ void init(int M, int N, int G_, int c_) { nM = M / BM; nN = N / BM; nwg = nM * nN; G = G_; c = c_; }
    __device__ bool next(int i, Unit& u) const {
        const long L = (long)i * G + c; if (L >= nwg) return false;
        int wgid = (int)L; { const int q = nwg / NXCD, r = nwg % NXCD, xcd = wgid % NXCD, off = wgid / NXCD; wgid = (xcd < r ? xcd * (q + 1) : r * (q + 1) + (xcd - r) * q) + off; }
        const int nig = WGM * nN, gid = wgid / nig, fm = gid * WGM, gsz = (nM - fm) < WGM ? (nM - fm) : WGM;
        u.pm = fm + ((wgid % nig) % gsz); u.pn = (wgid % nig) / gsz; return true;
    }
};
struct OrderE { int G, c; __device__ bool next(int i, Unit& u) const { const int L = i * G + c; if (L >= SG * 3) return false; const int g = L / 3; u.pm = 3 * g + L % 3; u.pn = g; return true; } };
struct OrderY { int G, c; __device__ bool next(int i, Unit& u) const { const int L = i * G + c; if (L >= SG * 8) return false; const int g = L >> 3, r = L & 7; u.pm = 3 * g + (r >> 2); u.pn = 4 * g + (r & 3); return true; } };

__device__ __forceinline__ unsigned cvt_pk_bf16(float lo, float hi) { unsigned r; asm volatile("v_cvt_pk_bf16_f32 %0, %1, %2" : "=v"(r) : "v"(lo), "v"(hi)); return r; }

template <class Epi, class Sched, bool ALIGN_EPI>
__device__ __forceinline__ void gemm_phase(PG8_LAS unsigned char* lds, const Gemm g, const Sched& S, const Epi& E) {
    const int tid = tid_fresh(), wid = __builtin_amdgcn_readfirstlane(tid >> 6), lane = tid & 63, wr = wid >> 2, wc = wid & 3, fr = lane & 15, fq = lane >> 4;
    int K_ = g.K; asm volatile("" : "+s"(K_));
    const int K = K_, nt = K / BK;
    unsigned voffA[2], voffB[2];
#pragma unroll
    for (int i = 0; i < 2; ++i) { int R, C; stage_rc(tid * 16 + i * 8192, R, C); const int Rb = Epi::PERM ? ((R & ~31) + perm32(R & 31)) : R;
        voffA[i] = (unsigned)(R * g.lda + C) * 2u; voffB[i] = (unsigned)(Rb * g.ldb + C) * 2u; }
    const size_t kstep = (size_t)(BK * 2);
    const size_t hA = (size_t)HALF * g.lda * 2, hB = (size_t)HALF * g.ldb * 2, tA = 2 * hA, tB = 2 * hB;
    const unsigned ldsw = (unsigned)wid * 1024u;
    const int aoff = lds_byte(wr * 64 + fr, fq * 8), boff = lds_byte(wc * 32 + fr, fq * 8);
#define PG8_SA(b, h) (((b) * 2 + (h)) * HTB)
#define PG8_SB(b, h) ((4 + (b) * 2 + (h)) * HTB)
#define PG8_STAGE(bufoff, gbase, voff) do { _Pragma("unroll") for (int _i = 0; _i < 2; ++_i) \
        __builtin_amdgcn_global_load_lds((const unsigned*)((const char*)(gbase) + (voff)[_i]), (PG8_LAS unsigned*)(lds + (bufoff) + ldsw + _i * 8192), 16, 0, 0); } while (0)
#define PG8_LDA(dst, b, h) do { _Pragma("unroll") for (int m = 0; m < 4; ++m) _Pragma("unroll") for (int k = 0; k < 2; ++k) dst[m][k] = *(const PG8_LAS bf16x8*)(lds + PG8_SA(b, h) + aoff + m * 2048 + k * 1024); } while (0)
#define PG8_LDB(dst, b, h) do { _Pragma("unroll") for (int n = 0; n < 2; ++n) _Pragma("unroll") for (int k = 0; k < 2; ++k) dst[n][k] = *(const PG8_LAS bf16x8*)(lds + PG8_SB(b, h) + boff + n * 2048 + k * 1024); } while (0)
#define PG8_MMA(ai, bj, At, Bt) do { __builtin_amdgcn_s_setprio(1); _Pragma("unroll") for (int m = 0; m < 4; ++m) _Pragma("unroll") for (int n = 0; n < 2; ++n) _Pragma("unroll") for (int k = 0; k < 2; ++k) \
        acc[ai][bj][m][n] = __builtin_amdgcn_mfma_f32_16x16x32_bf16(Bt[n][k], At[m][k], acc[ai][bj][m][n], 0, 0, 0); __builtin_amdgcn_s_setprio(0); } while (0)
#define PG8_WAIT_V(n) asm volatile("s_waitcnt vmcnt(" #n ")" ::: "memory")
#define PG8_WAIT_L(n) asm volatile("s_waitcnt lgkmcnt(" #n ")" ::: "memory")
#define PG8_BAR __builtin_amdgcn_s_barrier()
#define PG8_SCHED __builtin_amdgcn_sched_barrier(0)
    Unit cur, nxt; int ui = 0;
    if (!S.next(0, cur)) return;
    f32x4 acc[2][2][4][2];
#pragma unroll
    for (int a = 0; a < 2; ++a)
#pragma unroll
        for (int b = 0; b < 2; ++b)
#pragma unroll
            for (int m = 0; m < 4; ++m)
#pragma unroll
                for (int n = 0; n < 2; ++n) acc[a][b][m][n] = (f32x4){0.f, 0.f, 0.f, 0.f};
    bf16x8 At[4][2], B0[2][2], B1[2][2];
    const char* cA = (const char*)g.A + (size_t)cur.pm * tA; const char* cB = (const char*)g.Bt + (size_t)cur.pn * tB;
    PG8_STAGE(PG8_SB(0, 0), cB, voffB); PG8_STAGE(PG8_SB(0, 1), cB + hB, voffB); PG8_STAGE(PG8_SA(0, 0), cA, voffA); PG8_STAGE(PG8_SA(0, 1), cA + hA, voffA);
    if (wr == 1) PG8_BAR;
    PG8_WAIT_V(2); PG8_BAR;
    PG8_STAGE(PG8_SB(1, 0), cB + kstep, voffB); PG8_STAGE(PG8_SA(1, 0), cA + kstep, voffA); PG8_STAGE(PG8_SB(1, 1), cB + hB + kstep, voffB);
    PG8_WAIT_V(6); PG8_BAR;
    for (;;) {
        const bool has_next = S.next(ui + 1, nxt);
        const char* nA = has_next ? (const char*)g.A + (size_t)nxt.pm * tA : cA; const char* nB = has_next ? (const char*)g.Bt + (size_t)nxt.pn * tB : cB;
        for (int t = 0; t < nt; t += 2) {
            const bool last = (t == nt - 2);
            const char* a1 = cA + (size_t)(t + 1) * kstep;
            const char* a2 = last ? nA : cA + (size_t)(t + 2) * kstep; const char* b2 = last ? nB : cB + (size_t)(t + 2) * kstep;
            const char* a3 = a2 + kstep; const char* b3 = b2 + kstep;
            PG8_LDB(B0, 0, 0); PG8_LDB(B1, 0, 1); PG8_SCHED; PG8_LDA(At, 0, 0); PG8_STAGE(PG8_SA(1, 1), a1 + hA, voffA);
            PG8_WAIT_V(8); PG8_WAIT_L(0); PG8_BAR; PG8_MMA(0, 0, At, B0); PG8_MMA(0, 1, At, B1); PG8_BAR; PG8_SCHED;
            PG8_LDA(At, 0, 1); PG8_STAGE(PG8_SB(0, 0), b2, voffB); PG8_STAGE(PG8_SB(0, 1), b2 + hB, voffB); PG8_STAGE(PG8_SA(0, 0), a2, voffA);
            PG8_WAIT_V(8); PG8_WAIT_L(0); PG8_BAR; PG8_MMA(1, 0, At, B0); PG8_MMA(1, 1, At, B1); PG8_BAR; PG8_SCHED;
            PG8_LDB(B0, 1, 0); PG8_LDB(B1, 1, 1); PG8_SCHED; PG8_LDA(At, 1, 0); PG8_STAGE(PG8_SA(0, 1), a2 + hA, voffA);
            PG8_WAIT_V(8); PG8_WAIT_L(0); PG8_BAR; PG8_MMA(0, 0, At, B0); PG8_MMA(0, 1, At, B1); PG8_BAR; PG8_SCHED;
            PG8_LDA(At, 1, 1); PG8_STAGE(PG8_SB(1, 0), b3, voffB); PG8_STAGE(PG8_SB(1, 1), b3 + hB, voffB); PG8_STAGE(PG8_SA(1, 0), a3, voffA);
            PG8_WAIT_V(8); PG8_WAIT_L(0); PG8_BAR; PG8_MMA(1, 0, At, B0); PG8_MMA(1, 1, At, B1); PG8_BAR; PG8_SCHED;
        }
        if constexpr (ALIGN_EPI) { if (wr == 0) PG8_BAR; }
        E(acc, cur, wr, wc, fr, fq);
        if (!has_next) break;
#pragma unroll
        for (int a = 0; a < 2; ++a)
#pragma unroll
            for (int b = 0; b < 2; ++b)
#pragma unroll
                for (int m = 0; m < 4; ++m)
#pragma unroll
                    for (int n = 0; n < 2; ++n) acc[a][b][m][n] = (f32x4){0.f, 0.f, 0.f, 0.f};
        cur = nxt; cA = nA; cB = nB; ++ui;
        if constexpr (ALIGN_EPI) { if (wr == 1) PG8_BAR; }
    }
    PG8_WAIT_V(0);
    if constexpr (!ALIGN_EPI) { if (wr == 0) PG8_BAR; }
    PG8_BAR;
#undef PG8_SA
#undef PG8_SB
#undef PG8_STAGE
#undef PG8_LDA
#undef PG8_LDB
#undef PG8_MMA
#undef PG8_WAIT_V
#undef PG8_WAIT_L
#undef PG8_BAR
#undef PG8_SCHED
}

__device__ __forceinline__ float sigmoidf_fast(float x) { return __builtin_amdgcn_rcpf(1.0f + __builtin_amdgcn_exp2f(-1.4426950408889634f * x)); }

template <bool MOD> struct EpiSwiGLU {
    static constexpr bool PERM = true;
    bf16_t* H; int ldh; const float* RS; const float* SHW;
    __device__ __forceinline__ void operator()(const f32x4 (&acc)[2][2][4][2], const Unit& u, int wr, int wc, int fr, int fq) const {
        const int row0 = u.pm * BM + wr * 64 + fr, c0 = wc * 32 + 8 * fq, col0 = u.pn * HALF + c0; const int mrow = u.pm >= NLAT / BM ? NB : (u.pm >> 4);
        f32x4 sg[2], su[2];
        if (MOD) {
#pragma unroll
            for (int n = 0; n < 2; ++n) { sg[n] = *(const f32x4*)(SHW + (size_t)mrow * (2 * DFF) + u.pn * BM + c0 + 4 * n); su[n] = *(const f32x4*)(SHW + (size_t)mrow * (2 * DFF) + u.pn * BM + HALF + c0 + 4 * n); } }
#pragma unroll
        for (int ai = 0; ai < 2; ++ai)
#pragma unroll
            for (int m = 0; m < 4; ++m) { const int row = row0 + ai * HALF + m * 16; bf16_t* rowp = H + (size_t)row * ldh + col0;
                float rinv = 1.f; if (MOD) { const f32x4 q = *(const f32x4*)(RS + (size_t)row * 4); rinv = 1.0f / sqrtf(((q[0] + q[1]) + (q[2] + q[3])) * (1.0f / DM) + EPS); }
                float h[8];
#pragma unroll
                for (int n = 0; n < 2; ++n)
#pragma unroll
                    for (int j = 0; j < 4; ++j) { float gt = acc[ai][0][m][n][j], up = acc[ai][1][m][n][j]; if (MOD) { gt = gt * rinv + sg[n][j]; up = up * rinv + su[n][j]; } h[4 * n + j] = gt * sigmoidf_fast(gt) * up; }
                u32x4 w; w.x = cvt_pk_bf16(h[0], h[1]); w.y = cvt_pk_bf16(h[2], h[3]); w.z = cvt_pk_bf16(h[4], h[5]); w.w = cvt_pk_bf16(h[6], h[7]);
                *(u32x4*)rowp = w; }
    }
};
template <bool MOD> struct EpiResid {
    static constexpr bool PERM = true;
    const float* base; float* out; const float* cbase; float* cout; const float* gate;
    const float* gvec; const float* scale; bf16_t* A2; float* RS; float coef;
    __device__ __forceinline__ void operator()(const f32x4 (&acc)[2][2][4][2], const Unit& u, int wr, int wc, int fr, int fq) const {
        const bool isc = u.pm >= NLAT / BM; const int mrow = isc ? NB : (u.pm >> 4);
        const float* bs = isc ? cbase - (size_t)NLAT * DM : base; float* os = isc ? cout - (size_t)NLAT * DM : out;
        const int row0 = u.pm * BM + wr * 64 + fr, col0 = u.pn * BM + wc * 32 + 8 * fq;
        PG8_LAS float* part = (PG8_LAS float*)(unsigned)(STAGE_BYTES + 1024);
        f32x4 gv[2][2], G[2][2];
#pragma unroll
        for (int bj = 0; bj < 2; ++bj)
#pragma unroll
            for (int n = 0; n < 2; ++n) { gv[bj][n] = *(const f32x4*)(gate + (size_t)mrow * NMODV + col0 + bj * HALF + n * 4) * coef;
                if (MOD) G[bj][n] = *(const f32x4*)(gvec + col0 + bj * HALF + n * 4) * (*(const f32x4*)(scale + (size_t)mrow * NMODV + col0 + bj * HALF + n * 4) + 1.0f); }
#pragma unroll
        for (int ai = 0; ai < 2; ++ai)
#pragma unroll
            for (int m = 0; m < 4; ++m) { const size_t off = (size_t)(row0 + ai * HALF + m * 16) * DM + col0; float ss = 0.f;
#pragma unroll
                for (int bj = 0; bj < 2; ++bj) {
                    const f32x4 x0 = *(const f32x4*)(bs + off + bj * HALF) + gv[bj][0] * acc[ai][bj][m][0], x1 = *(const f32x4*)(bs + off + bj * HALF + 4) + gv[bj][1] * acc[ai][bj][m][1];
                    *(f32x4*)(os + off + bj * HALF) = x0; *(f32x4*)(os + off + bj * HALF + 4) = x1;
                    if (MOD) { ss += (x0[0] * x0[0] + x0[1] * x0[1]) + (x0[2] * x0[2] + x0[3] * x0[3]) + (x1[0] * x1[0] + x1[1] * x1[1]) + (x1[2] * x1[2] + x1[3] * x1[3]);
                        const f32x4 a0 = x0 * G[bj][0], a1 = x1 * G[bj][1];
                        u32x4 w; w.x = cvt_pk_bf16(a0[0], a0[1]); w.y = cvt_pk_bf16(a0[2], a0[3]); w.z = cvt_pk_bf16(a1[0], a1[1]); w.w = cvt_pk_bf16(a1[2], a1[3]);
                        *(u32x4*)(A2 + off + bj * HALF) = w; } }
                if (MOD) { ss += __shfl_xor(ss, 16); ss += __shfl_xor(ss, 32); if (fq == 0) part[wc * BM + ai * HALF + wr * 64 + m * 16 + fr] = ss; }
                if (m & 1) asm volatile("" ::: "memory"); }
        if (MOD) {
            asm volatile("s_waitcnt lgkmcnt(0)\n\ts_barrier" ::: "memory");
            const int tid = (wr * 4 + wc) * 64 + fq * 16 + fr;
            if (tid < BM) RS[(size_t)(u.pm * BM + tid) * 4 + u.pn] = (part[tid] + part[BM + tid]) + (part[2 * BM + tid] + part[3 * BM + tid]);
        }
    }
};
template <bool MOD> struct EpiF32 {
    static constexpr bool PERM = false;
    float* C; int ldc; int tile_cols; const float* RS; const float* SHW;
    __device__ __forceinline__ void operator()(const f32x4 (&acc)[2][2][4][2], const Unit& u, int wr, int wc, int fr, int fq) const {
        const int row0 = u.pm * BM + wr * 64 + fr, col0 = (tile_cols ? 0 : u.pn * BM) + wc * 32 + 4 * fq; const int mrow = u.pm >= NLAT / BM ? NB : (u.pm >> 4);
        f32x4 sh[2][2];
        if (MOD) {
#pragma unroll
            for (int bj = 0; bj < 2; ++bj)
#pragma unroll
                for (int n = 0; n < 2; ++n) sh[bj][n] = *(const f32x4*)(SHW + (size_t)mrow * ldc + col0 + bj * HALF + n * 16); }
#pragma unroll
        for (int ai = 0; ai < 2; ++ai)
#pragma unroll
            for (int m = 0; m < 4; ++m) { const int row = row0 + ai * HALF + m * 16; float* rowp = C + (size_t)row * ldc + col0;
                float rinv = 1.f; if (MOD) { const f32x4 q = *(const f32x4*)(RS + (size_t)row * 4); rinv = 1.0f / sqrtf(((q[0] + q[1]) + (q[2] + q[3])) * (1.0f / DM) + EPS); }
#pragma unroll
                for (int bj = 0; bj < 2; ++bj)
#pragma unroll
                    for (int n = 0; n < 2; ++n) { f32x4 v = acc[ai][bj][m][n]; if (MOD) v = v * rinv + sh[bj][n]; *(f32x4*)(rowp + bj * HALF + n * 16) = v; } }
    }
};
struct EpiQ {
    static constexpr bool PERM = true;
    bf16_t* Q; const float* rope;
    __device__ __forceinline__ void operator()(const f32x4 (&acc)[2][2][4][2], const Unit& u, int wr, int wc, int fr, int fq) const {
        const int row0 = u.pm * BM + wr * 64 + fr, b = row0 >> 12, t0 = row0 & (SEQ - 1);
#pragma unroll
        for (int bj = 0; bj < 2; ++bj) { const int col8 = u.pn * BM + bj * HALF + wc * 32 + 8 * fq; if (col8 >= NH * DQK) continue;
            const int h = col8 / DQK, d = col8 - h * DQK; const bool rp = d >= 64;
            const unsigned qoff = (unsigned)((((b * NH + h) * SEQ + t0) * DQK + d) * 2);
            const unsigned roff = (unsigned)((t0 * 16 + (rp ? ((d - 64) >> 1) : 0)) * 8);
#pragma unroll
            for (int ai = 0; ai < 2; ++ai)
#pragma unroll
                for (int m = 0; m < 4; ++m) { const unsigned dr = (unsigned)(ai * HALF + m * 16);
                    float v[8];
#pragma unroll
                    for (int n = 0; n < 2; ++n)
#pragma unroll
                        for (int j = 0; j < 4; ++j) v[4 * n + j] = acc[ai][bj][m][n][j] * QSCALE;
                    if (rp) { const float* cs = (const float*)((const char*)rope + (roff + dr * 128u)); const f32x4 c0 = *(const f32x4*)cs, c1 = *(const f32x4*)(cs + 4);
                        const float cc[4] = {c0[0], c0[2], c1[0], c1[2]}, ss[4] = {c0[1], c0[3], c1[1], c1[3]};
#pragma unroll
                        for (int i = 0; i < 4; ++i) { const float t1 = v[2 * i], t2 = v[2 * i + 1]; v[2 * i] = t1 * cc[i] - t2 * ss[i]; v[2 * i + 1] = t1 * ss[i] + t2 * cc[i]; } }
                    u32x4 w; w.x = cvt_pk_bf16(v[0], v[1]); w.y = cvt_pk_bf16(v[2], v[3]); w.z = cvt_pk_bf16(v[4], v[5]); w.w = cvt_pk_bf16(v[6], v[7]);
                    *(u32x4*)((char*)Q + (qoff + dr * (unsigned)(DQK * 2))) = w; asm volatile("" ::: "memory"); } }
    }
};
struct EpiKV {
    static constexpr bool PERM = true;
    bf16_t* Kf; bf16_t* Vf;
    __device__ __forceinline__ void operator()(const f32x4 (&acc)[2][2][4][2], const Unit& u, int wr, int wc, int fr, int fq) const {
        const int row0 = u.pm * BM + wr * 64 + fr; const bool isc = u.pm >= NLAT / BM; int b, key0;
        if (isc) { const int r = row0 - NLAT; b = r >> 8; key0 = r & (CTXL - 1); } else { b = row0 >> 12; key0 = CTXL + (row0 & (SEQ - 1)); }
        const bool isk = wc < 2; const int d = (wc & 1) * 32 + 8 * fq;
        char* basep = isk ? (char*)Kf : (char*)Vf; const unsigned rs = isk ? (unsigned)(DQK * 2) : (unsigned)(DV * 2);
#pragma unroll
        for (int bj = 0; bj < 2; ++bj) { const int h = u.pn * 2 + bj;
            const unsigned off = (unsigned)((b * NH + h) * SKV + key0) * rs + (unsigned)(d * 2);
#pragma unroll
            for (int ai = 0; ai < 2; ++ai)
#pragma unroll
                for (int m = 0; m < 4; ++m) { const unsigned dr = (unsigned)(ai * HALF + m * 16);
                    const f32x4 v0 = acc[ai][bj][m][0], v1 = acc[ai][bj][m][1];
                    u32x4 w; w.x = cvt_pk_bf16(v0[0], v0[1]); w.y = cvt_pk_bf16(v0[2], v0[3]); w.z = cvt_pk_bf16(v1[0], v1[1]); w.w = cvt_pk_bf16(v1[2], v1[3]);
                    *(u32x4*)(basep + (off + dr * rs)) = w; asm volatile("" ::: "memory"); } }
    }
};
struct EpiY {
    static constexpr bool PERM = true;
    bf16_t* Zs;
    __device__ __forceinline__ void operator()(const f32x4 (&acc)[2][2][4][2], const Unit& u, int wr, int wc, int fr, int fq) const {
        const int g = u.pn >> 2, rl0 = (u.pm - 3 * g) * BM + wr * 64 + fr;
#pragma unroll
        for (int bj = 0; bj < 2; ++bj) { const int coll = (u.pn & 3) * BM + bj * HALF + wc * 32 + 8 * fq, t = coll >> 4, co8 = coll & 15;
#pragma unroll
            for (int ai = 0; ai < 2; ++ai)
#pragma unroll
                for (int m = 0; m < 4; ++m) { const int rl = rl0 + ai * HALF + m * 16, b = rl >> 6, k = rl & 63; const size_t tok = (size_t)b * SEQ + k * CH + t;
                    float z[8];
#pragma unroll
                    for (int n = 0; n < 2; ++n)
#pragma unroll
                        for (int j = 0; j < 4; ++j) { const float x = acc[ai][bj][m][n][j]; const float in = 1.5957691216057308f * (x + 0.044715f * x * x * x); z[4 * n + j] = x * sigmoidf_fast(in); }
                    u32x4 w; w.x = cvt_pk_bf16(z[0], z[1]); w.y = cvt_pk_bf16(z[2], z[3]); w.z = cvt_pk_bf16(z[4], z[5]); w.w = cvt_pk_bf16(z[6], z[7]);
                    *(u32x4*)(Zs + tok * 256 + g * 16 + co8) = w; } }
    }
};
struct EpiGLU {
    static constexpr bool PERM = true;
    bf16_t* O; int ldo; int coff;
    __device__ __forceinline__ void operator()(const f32x4 (&acc)[2][2][4][2], const Unit& u, int wr, int wc, int fr, int fq) const {
        const int row0 = u.pm * BM + wr * 64 + fr, col0 = coff + u.pn * HALF + wc * 32 + 8 * fq;
#pragma unroll
        for (int ai = 0; ai < 2; ++ai)
#pragma unroll
            for (int m = 0; m < 4; ++m) { bf16_t* rowp = O + (size_t)(row0 + ai * HALF + m * 16) * ldo + col0;
                float h[8];
#pragma unroll
                for (int n = 0; n < 2; ++n)
#pragma unroll
                    for (int j = 0; j < 4; ++j) h[4 * n + j] = acc[ai][0][m][n][j] * sigmoidf_fast(acc[ai][1][m][n][j]);
                u32x4 w; w.x = cvt_pk_bf16(h[0], h[1]); w.y = cvt_pk_bf16(h[2], h[3]); w.z = cvt_pk_bf16(h[4], h[5]); w.w = cvt_pk_bf16(h[6], h[7]);
                *(u32x4*)rowp = w; }
    }
};
}

namespace att {
using bf16x8 = __attribute__((ext_vector_type(8))) short;
using s16x4  = __attribute__((ext_vector_type(4))) short;
using f32x16 = __attribute__((ext_vector_type(16))) float;
using u32x4  = __attribute__((ext_vector_type(4))) unsigned;
constexpr int NW = 8, QBLK = 32, KVBLK = 64, NT = SKV / KVBLK;
constexpr int KROW = 208;
constexpr int SHM_K = KVBLK * KROW, SHM_V = KVBLK * DV * 2;
constexpr int OFF_V = 0, OFF_K = 2 * SHM_V, OFF_WS = OFF_K + 2 * SHM_K, OFF_OST = OFF_WS + NW * 64 * 4, LDS_BYTES = OFF_OST + NW * 4096;
constexpr float THRL = 8.0f;
#define SBAR() __builtin_amdgcn_sched_barrier(0)
__device__ __forceinline__ int crow(int r, int hi) { return (r & 3) + 8 * (r >> 2) + 4 * hi; }
__device__ __forceinline__ unsigned cvtpk(float lo, float hi) { unsigned r; asm volatile("v_cvt_pk_bf16_f32 %0, %1, %2" : "=v"(r) : "v"(lo), "v"(hi)); return r; }
template <bool FIRST> __device__ __forceinline__ void partialSM(f32x16& p0, f32x16& p1, float& m_reg, f32x16& negm, float& alpha) {
  float pmax = p0[0];
#pragma unroll
  for (int r = 1; r < 16; ++r) pmax = fmaxf(pmax, p0[r]);
#pragma unroll
  for (int r = 0; r < 16; ++r) pmax = fmaxf(pmax, p1[r]);
  { auto rr = __builtin_amdgcn_permlane32_swap(__float_as_uint(pmax), __float_as_uint(pmax), false, false);
    pmax = fmaxf(__uint_as_float(rr[0]), __uint_as_float(rr[1])); }
  if (!FIRST && __builtin_expect(__all(pmax <= THRL), 1)) { alpha = 1.f; }
  else { const float delta = FIRST ? pmax : fmaxf(pmax, 0.f); alpha = FIRST ? 0.f : __builtin_amdgcn_exp2f(-delta); m_reg += delta;
#pragma unroll
    for (int r = 0; r < 16; ++r) { p0[r] -= delta; p1[r] -= delta; }
    const float nm = -m_reg;
#pragma unroll
    for (int r = 0; r < 16; ++r) negm[r] = nm; }
#pragma unroll
  for (int r = 0; r < 16; ++r) p0[r] = __builtin_amdgcn_exp2f(p0[r]);
}
__device__ __forceinline__ void finishSM(f32x16& p0, f32x16& p1, float alpha, float& l_reg, bf16x8& pa0, bf16x8& pa1, bf16x8& pa2, bf16x8& pa3) {
#pragma unroll
  for (int r = 0; r < 16; ++r) p1[r] = __builtin_amdgcn_exp2f(p1[r]);
  float ps = 0;
#pragma unroll
  for (int r = 0; r < 16; ++r) ps += p0[r];
#pragma unroll
  for (int r = 0; r < 16; ++r) ps += p1[r];
  { auto rr = __builtin_amdgcn_permlane32_swap(__float_as_uint(ps), __float_as_uint(ps), false, false);
    ps = __uint_as_float(rr[0]) + __uint_as_float(rr[1]); }
  l_reg = l_reg * alpha + ps;
#define PK4(P, BASE, OUT) do { unsigned a0 = cvtpk(P[BASE + 0], P[BASE + 1]), a1 = cvtpk(P[BASE + 2], P[BASE + 3]);   \
    unsigned b0 = cvtpk(P[BASE + 4], P[BASE + 5]), b1 = cvtpk(P[BASE + 6], P[BASE + 7]);                              \
    auto r0 = __builtin_amdgcn_permlane32_swap(a0, b0, false, false); auto r1 = __builtin_amdgcn_permlane32_swap(a1, b1, false, false); \
    u32x4 w = {r0[0], r1[0], r0[1], r1[1]}; OUT = *reinterpret_cast<bf16x8*>(&w); } while (0)
  PK4(p0, 0, pa0); PK4(p0, 8, pa1); PK4(p1, 0, pa2); PK4(p1, 8, pa3);
#undef PK4
}
__device__ __forceinline__ void qkt(f32x16& p0, f32x16& p1, const char* Ks, const bf16x8* qr, const f32x16& negm, int r32, int hi) {
#pragma unroll
  for (int d0 = 0; d0 < 6; ++d0) { const int cb = (d0 * 16 + hi * 8) * 2;
    const bf16x8 b0 = *reinterpret_cast<const bf16x8*>(Ks + r32 * KROW + cb);
    const bf16x8 b1 = *reinterpret_cast<const bf16x8*>(Ks + (32 + r32) * KROW + cb);
    if (d0 == 0) { p0 = __builtin_amdgcn_mfma_f32_32x32x16_bf16(b0, qr[0], negm, 0, 0, 0); p1 = __builtin_amdgcn_mfma_f32_32x32x16_bf16(b1, qr[0], negm, 0, 0, 0); }
    else { p0 = __builtin_amdgcn_mfma_f32_32x32x16_bf16(b0, qr[d0], p0, 0, 0, 0); p1 = __builtin_amdgcn_mfma_f32_32x32x16_bf16(b1, qr[d0], p1, 0, 0, 0); } }
}
__device__ __forceinline__ int v_st(int k, int c) { const int kk = (k & ~0xC) | ((k & 4) << 1) | ((k & 8) >> 1); return ((kk >> 3) * 2 + (c >> 5)) * 512 + ((kk & 7) * 32 + (c & 31)) * 2; }
__device__ __forceinline__ int v_rd_base(int lane) { return ((lane & 3) << 3) | (((lane >> 2) & 3) << 6) | (((lane >> 4) & 1) << 5) | (((lane >> 5) & 1) << 8); }
constexpr int v_rd_off(int d0, int ks, int half) { return d0 * 512 + ks * 2048 + half * 1024; }
template <int OFF> __device__ __forceinline__ s16x4 tr_read(int vb) { s16x4 r; asm volatile("ds_read_b64_tr_b16 %0, %1 offset:%2" : "=&v"(r) : "v"(vb), "i"(OFF) : "memory"); return r; }
template <int D0> __device__ __forceinline__ void pv_one(f32x16& od, int vb, bf16x8 pa0, bf16x8 pa1, bf16x8 pa2, bf16x8 pa3) {
  const s16x4 l0 = tr_read<v_rd_off(D0, 0, 0)>(vb), h0 = tr_read<v_rd_off(D0, 0, 1)>(vb), l1 = tr_read<v_rd_off(D0, 1, 0)>(vb), h1 = tr_read<v_rd_off(D0, 1, 1)>(vb);
  const s16x4 l2 = tr_read<v_rd_off(D0, 2, 0)>(vb), h2 = tr_read<v_rd_off(D0, 2, 1)>(vb), l3 = tr_read<v_rd_off(D0, 3, 0)>(vb), h3 = tr_read<v_rd_off(D0, 3, 1)>(vb);
  asm volatile("s_waitcnt lgkmcnt(0)" ::: "memory"); SBAR();
#define PK(L, H) (bf16x8){L[0], L[1], L[2], L[3], H[0], H[1], H[2], H[3]}
  od = __builtin_amdgcn_mfma_f32_32x32x16_bf16(pa0, PK(l0, h0), od, 0, 0, 0);
  od = __builtin_amdgcn_mfma_f32_32x32x16_bf16(pa1, PK(l1, h1), od, 0, 0, 0);
  od = __builtin_amdgcn_mfma_f32_32x32x16_bf16(pa2, PK(l2, h2), od, 0, 0, 0);
  od = __builtin_amdgcn_mfma_f32_32x32x16_bf16(pa3, PK(l3, h3), od, 0, 0, 0);
#undef PK
}
__device__ __forceinline__ void pv_d0(f32x16* o, int vb, bf16x8 pa0, bf16x8 pa1, bf16x8 pa2, bf16x8 pa3) {
  pv_one<0>(o[0], vb, pa0, pa1, pa2, pa3); pv_one<1>(o[1], vb, pa0, pa1, pa2, pa3);
}
__device__ __forceinline__ void attn_unit(const unsigned short* __restrict__ Qb, const unsigned short* __restrict__ Kh, const unsigned short* __restrict__ Vh, unsigned short* __restrict__ Ob, int ldo, char* lds) {
  const int tid = tid_fresh(), wid = tid >> 6, lane = tid & 63, r32 = lane & 31, hi = lane >> 5;
  char* V_lds = lds + OFF_V; char* K_lds = lds + OFF_K;
  float* ws = (float*)(lds + OFF_WS) + wid * 64; float* li_l = ws; float* al_l = ws + 32;
  float m_reg = 0.f, l_reg = 0; f32x16 o[2] = {}; bf16x8 qr[6]; f32x16 negm = {}; asm volatile("" : "+v"(negm));
  const unsigned short* Qw = Qb + (size_t)(wid * QBLK + r32) * DQK + hi * 8;
#pragma unroll
  for (int d0 = 0; d0 < 6; ++d0) qr[d0] = *reinterpret_cast<const bf16x8*>(Qw + d0 * 16);
  const bool k2 = wid < 4; const int c2 = k2 ? 512 + tid : tid;
  const int kst0 = (tid / 12) * KROW + (tid % 12) * 16, kst1 = (c2 / 12) * KROW + (c2 % 12) * 16, vst = v_st(tid >> 3, (tid & 7) * 8);
  const int vb0 = (int)(uintptr_t)V_lds + v_rd_base(lane);
  struct { bf16x8 k0, k1, v; } sr_[2];
#define SLOAD(i, key0) do { sr_[i].k0 = *reinterpret_cast<const bf16x8*>(Kh + (size_t)(key0) * DQK + tid * 8); sr_[i].k1 = *reinterpret_cast<const bf16x8*>(Kh + (size_t)(key0) * DQK + c2 * 8); \
    sr_[i].v = *reinterpret_cast<const bf16x8*>(Vh + (size_t)(key0) * DV + tid * 8); } while (0)
#define SWRITE(b, i) do { *(bf16x8*)(K_lds + (b) * SHM_K + kst0) = sr_[i].k0; if (k2) *(bf16x8*)(K_lds + (b) * SHM_K + kst1) = sr_[i].k1; *(bf16x8*)(V_lds + (b) * SHM_V + vst) = sr_[i].v; } while (0)
#define SWAIT() asm volatile("s_waitcnt vmcnt(3)" ::: "memory")
#define RESC(a) do { if (__any((a) < 1.f)) { if (hi == 0) al_l[r32] = (a); asm volatile("s_waitcnt lgkmcnt(0)" ::: "memory"); \
    _Pragma("unroll") for (int d = 0; d < 2; ++d) _Pragma("unroll") for (int r = 0; r < 16; ++r) o[d][r] *= al_l[crow(r, hi)]; } } while (0)
  f32x16 pA0, pA1, pB0, pB1; float alA, alB; bf16x8 pa0, pa1, pa2, pa3;
  SLOAD(0, 0); asm volatile("s_waitcnt vmcnt(0)" ::: "memory"); SWRITE(0, 0); __syncthreads();
  qkt(pA0, pA1, K_lds, qr, negm, r32, hi); partialSM<true>(pA0, pA1, m_reg, negm, alA);
  SLOAD(1, KVBLK); SLOAD(0, 2 * KVBLK);
  SWAIT(); SWRITE(1, 1); __syncthreads();
  for (int j = 1; j + 1 < NT; j += 2) {
    SBAR(); qkt(pB0, pB1, K_lds + SHM_K, qr, negm, r32, hi);
    finishSM(pA0, pA1, alA, l_reg, pa0, pa1, pa2, pa3); SBAR();
    SLOAD(1, (j + 2) * KVBLK); SBAR();
    pv_d0(o, vb0, pa0, pa1, pa2, pa3); partialSM<false>(pB0, pB1, m_reg, negm, alB);
    __syncthreads(); SWAIT(); SWRITE(0, 0);
    RESC(alB); __syncthreads();
    SBAR(); qkt(pA0, pA1, K_lds, qr, negm, r32, hi);
    finishSM(pB0, pB1, alB, l_reg, pa0, pa1, pa2, pa3); SBAR();
    if (j + 3 < NT) SLOAD(0, (j + 3) * KVBLK); SBAR();
    pv_d0(o, vb0 + SHM_V, pa0, pa1, pa2, pa3); partialSM<false>(pA0, pA1, m_reg, negm, alA);
    __syncthreads(); SWAIT(); SWRITE(1, 1);
    RESC(alA); __syncthreads();
  }
  SBAR(); qkt(pB0, pB1, K_lds + SHM_K, qr, negm, r32, hi);
  finishSM(pA0, pA1, alA, l_reg, pa0, pa1, pa2, pa3); SBAR();
  pv_d0(o, vb0, pa0, pa1, pa2, pa3); partialSM<false>(pB0, pB1, m_reg, negm, alB);
  __syncthreads(); RESC(alB);
  finishSM(pB0, pB1, alB, l_reg, pa0, pa1, pa2, pa3); SBAR();
  pv_d0(o, vb0 + SHM_V, pa0, pa1, pa2, pa3);
  if (hi == 0) li_l[r32] = l_reg; asm volatile("s_waitcnt lgkmcnt(0)" ::: "memory");
  float rli[16];
#pragma unroll
  for (int r = 0; r < 16; ++r) rli[r] = __builtin_amdgcn_rcpf(li_l[crow(r, hi)]);
  { unsigned short* stg = (unsigned short*)(lds + OFF_OST) + wid * 2048;
#pragma unroll
    for (int r = 0; r < 16; ++r) { const int orow = crow(r, hi);
#pragma unroll
      for (int d0 = 0; d0 < 2; ++d0) { const unsigned pk = cvtpk(o[d0][r] * rli[r], 0.f); stg[orow * 64 + d0 * 32 + r32] = (unsigned short)pk; } }
    asm volatile("s_waitcnt lgkmcnt(0)" ::: "memory");
    unsigned short* Ow = Ob + (size_t)(wid * QBLK) * ldo;
#pragma unroll
    for (int i = 0; i < 4; ++i) { const int row = i * 8 + (lane >> 3), ch = lane & 7; const u32x4 v = *(const u32x4*)(stg + row * 64 + ch * 8); *(u32x4*)(Ow + (size_t)row * ldo + ch * 8) = v; } }
  __syncthreads();
#undef SLOAD
#undef SWRITE
#undef SWAIT
#undef RESC
}
#undef SBAR
}

constexpr size_t al256(size_t x) { return (x + 255) / 256 * 256; }
constexpr size_t WS_CTL = 0, CTL_BYTES = 1u << 20;
constexpr size_t WS_MODS = WS_CTL + CTL_BYTES;
constexpr size_t WS_ROPE = WS_MODS + al256((size_t)9 * NMODV * 4);
constexpr size_t WS_KTAB = WS_ROPE + al256((size_t)SEQ * 16 * 2 * 4);
constexpr size_t WS_RS   = WS_KTAB + al256((size_t)SG * 2 * CH * 256 * 4);
constexpr size_t WS_SHWI = WS_RS + al256((size_t)MT * 4 * 4);
constexpr size_t WS_SHWG = WS_SHWI + al256((size_t)9 * DINP * 4);
constexpr size_t WS_WGU1 = WS_SHWG + al256((size_t)9 * 2 * DFF * 4);
constexpr size_t WS_WD1  = WS_WGU1 + al256((size_t)2 * DFF * DM * 2);
constexpr size_t WS_WGU2 = WS_WD1 + al256((size_t)DM * DFF * 2);
constexpr size_t WS_WD2  = WS_WGU2 + al256((size_t)2 * DFF * DM * 2);
constexpr size_t WS_WIN  = WS_WD2 + al256((size_t)DM * DFF * 2);
constexpr size_t WS_WUQ  = WS_WIN + al256((size_t)DINP * DM * 2);
constexpr size_t WS_WUKV = WS_WUQ + al256((size_t)1280 * 256 * 2);
constexpr size_t WS_WOUT = WS_WUKV + al256((size_t)1536 * 256 * 2);
constexpr size_t WS_WGLU = WS_WOUT + al256((size_t)DM * DM * 2);
constexpr size_t WS_BTY  = WS_WGLU + al256((size_t)512 * 256 * 2);
constexpr size_t WS_BTE  = WS_BTY + al256((size_t)SG * 1024 * AUK * 2);
constexpr size_t WS_AU   = WS_BTE + al256((size_t)SG * 256 * 1024 * 2);
constexpr size_t WS_E    = WS_AU + al256((size_t)SG * AUR * AUK * 2);
constexpr size_t WS_A    = WS_E + al256((size_t)SG * AUR * 256 * 4);
constexpr size_t WS_X1C  = WS_A + al256((size_t)MT * DM * 2);
constexpr size_t WS_CQ   = WS_X1C + al256((size_t)NCTX * DM * 4);
constexpr size_t WS_CKV  = WS_CQ + al256((size_t)NLAT * 256 * 2);
constexpr size_t WS_V    = WS_CKV + al256((size_t)MT * 256 * 2);
constexpr size_t WS_ZS   = WS_V + al256((size_t)NB * NH * SKV * DV * 2);
constexpr size_t WS_H    = WS_ZS + al256((size_t)NLAT * 256 * 2);
constexpr size_t WS_P    = WS_H;
constexpr size_t WS_Q    = WS_H;
constexpr size_t WS_K    = WS_P + al256((size_t)MT * DINP * 4);
constexpr size_t WS_END  = WS_H + al256((size_t)MT * DFF * 2);
static_assert(WS_K + (size_t)NB * NH * SKV * DQK * 2 <= WS_END && WS_P + (size_t)MT * DINP * 4 <= WS_END, "overlays fit in H");
constexpr size_t WS_A4 = WS_CQ;
static_assert(WS_A4 + (size_t)NLAT * DM * 2 <= WS_H, "A4 overlay fits before H");
static_assert(WS_END <= (size_t)512 * 1024 * 1024, "workspace map must fit 512 MiB");

#define LAS __attribute__((address_space(3)))
typedef unsigned short bf16;
typedef unsigned v4u __attribute__((ext_vector_type(4)));
typedef unsigned v2u __attribute__((ext_vector_type(2)));
typedef float f32x4 __attribute__((ext_vector_type(4)));
typedef float f32x2 __attribute__((ext_vector_type(2)));
#define LDS_WAIT() asm volatile("s_waitcnt lgkmcnt(0)" ::: "memory")
__device__ __forceinline__ unsigned f2bf(float f) { unsigned u = __builtin_bit_cast(unsigned, f); return (u + 0x7fffu + ((u >> 16) & 1u)) >> 16; }
__device__ __forceinline__ unsigned pk2(float lo, float hi) { return f2bf(lo) | (f2bf(hi) << 16); }
__device__ __forceinline__ float bf2f(unsigned short b) { return __builtin_bit_cast(float, (unsigned)b << 16); }
__device__ __forceinline__ float wave_sum(float v) {
#pragma unroll
    for (int o = 1; o < 64; o <<= 1) v += __shfl_xor(v, o);
    return v;
}

#define XB_TMO      128
#define XB_XCNT(j)  (256  + 64 * (j))
#define XB_XSUB(j)  (1280 + 64 * (j))
#define XB_XGEN(j)  (2304 + 64 * (j))
#define XB_TOP      3328
#define XB_TOPGEN   3392
#define XCD_BAR_WORDS 3456
#define XB_SPIN_CAP (1u << 22)
__device__ __forceinline__ unsigned xb_ld(unsigned* p)              { return __hip_atomic_load(p, __ATOMIC_RELAXED, __HIP_MEMORY_SCOPE_AGENT); }
__device__ __forceinline__ unsigned xb_add(unsigned* p, unsigned v) { return __hip_atomic_fetch_add(p, v, __ATOMIC_RELAXED, __HIP_MEMORY_SCOPE_AGENT); }
__device__ __forceinline__ unsigned xb_xcc_id() { return (unsigned)__builtin_amdgcn_s_getreg((3 << 11) | 20) & 0xFu; }
#define XB_SPIN(cond, bar) do { unsigned _sp = 0; while (cond) { __builtin_amdgcn_s_sleep(1); \
    if ((++_sp & 255u) == 0u) { if (xb_ld(&(bar)[XB_TMO])) break; if (_sp > XB_SPIN_CAP) { atomicAdd(&(bar)[XB_TMO], 1u); break; } } } } while (0)
struct XcdBarrier { unsigned* bar; unsigned x; volatile LAS unsigned* st; };
__device__ __forceinline__ XcdBarrier xcd_barrier_post(unsigned* bar, volatile LAS unsigned* st) {
    XcdBarrier b; b.bar = bar; b.x = xb_xcc_id(); b.st = st;
    if (threadIdx.x == 0) (void)xb_add(&bar[XB_XCNT(b.x)], 1u);
    return b;
}
__device__ __forceinline__ void xcd_barrier_complete(unsigned* bar, unsigned x, unsigned& nloc, unsigned& nx) {
    const unsigned G = gridDim.x * gridDim.y * gridDim.z;
    unsigned sum, cnt, mine, sp = 0u;
    for (;;) {
        sum = 0u; cnt = 0u; mine = 0u;
#pragma unroll
        for (unsigned j = 0; j < 16; ++j) { const unsigned c = xb_ld(&bar[XB_XCNT(j)]); sum += c; cnt += (c > 0u) ? 1u : 0u; mine = (j == x) ? c : mine; }
        if (sum == G) break;
        __builtin_amdgcn_s_sleep(1);
        if ((++sp & 255u) == 0u) { if (xb_ld(&bar[XB_TMO])) break; if (sp > XB_SPIN_CAP) { atomicAdd(&bar[XB_TMO], 1u); break; } }
    }
    nloc = mine > 0u ? mine : 1u; nx = cnt > 0u ? cnt : 1u;
}
__device__ __forceinline__ void xcd_barrier(const XcdBarrier& b) {
    asm volatile("s_waitcnt vmcnt(0)" ::: "memory");
    __syncthreads();
    if (threadIdx.x == 0) {
        unsigned* bar = b.bar;
        __builtin_amdgcn_s_waitcnt(0);
        unsigned nloc = b.st[0], nx = b.st[1];
        if (nloc == 0u) { xcd_barrier_complete(bar, b.x, nloc, nx); b.st[0] = nloc; b.st[1] = nx; }
        const unsigned old = xb_add(&bar[XB_XSUB(b.x)], 1u);
        const unsigned gen = old / nloc;
        if (old + 1u == (gen + 1u) * nloc) {
            __builtin_amdgcn_fence(__ATOMIC_RELEASE, "agent");
            asm volatile("s_waitcnt vmcnt(0)" ::: "memory");
            const unsigned og = xb_add(&bar[XB_TOP], 1u);
            const unsigned tg = og / nx;
            if (og + 1u == (tg + 1u) * nx) xb_add(&bar[XB_TOPGEN], 1u);
            else XB_SPIN(xb_ld(&bar[XB_TOPGEN]) == tg, bar);
            __builtin_amdgcn_fence(__ATOMIC_ACQUIRE, "agent");
            xb_add(&bar[XB_XGEN(b.x)], 1u);
            asm volatile("s_waitcnt vmcnt(0)" ::: "memory");
        } else {
            XB_SPIN(xb_ld(&bar[XB_XGEN(b.x)]) == gen, bar);
            __builtin_amdgcn_fence(__ATOMIC_ACQUIRE, "agent");
            asm volatile("s_waitcnt vmcnt(0)" ::: "memory");
        }
    }
    __syncthreads();
}

constexpr int NWAVES = 8, NTHREADS = 512, NPHASES = 17;
constexpr int RING_BYTES = 131072, LDSCTL_OFF = RING_BYTES, LDS_BYTES = 147456;
struct Args { const float* in[31]; float* out; unsigned char* ws; int ph_lo, ph_hi, use_bar, pad; };
enum { I_X = 0, I_C, I_CTX, I_CCTX, I_WMOD, I_BMOD, I_GFFN1, I_WGU1, I_WD1, I_GMIX, I_WIN, I_GCQ, I_WUQ, I_GCKV, I_WUKV, I_LAMRE, I_LAMIM, I_LOGDT, I_BRE, I_BIM, I_CRE, I_CIM,
       I_DSKIP, I_WGLU, I_GMLA, I_GSSM, I_WOUT, I_GFFN2, I_WGU2, I_WD2, I_GFINAL };

struct S5P { float lrdt, lidt_rev_hi; double lidt_rev; float fr, fi; };
__device__ __forceinline__ void s5_par(const float* lam_re, const float* lam_im, const float* log_dt, int d, int g, int p, float& lrdt, double& rev, float& fr, float& fi) {
    const float dt = __expf(log_dt[d * SG + g]); const float lr = fminf(lam_re[(d * SG + g) * SP + p], -1e-4f), li = lam_im[(d * SG + g) * SP + p];
    lrdt = lr * dt; rev = (double)li * (double)dt * 0.15915494309189535;
    double r1 = rev - __builtin_rint(rev); const float rf = (float)r1;
    const float mag = __expf(lrdt), ar = mag * __builtin_amdgcn_cosf(rf), ai = mag * __builtin_amdgcn_sinf(rf);
    const float den = lr * lr + li * li;
    fr = ((ar - 1.0f) * lr + ai * li) / den; fi = (ai * lr - (ar - 1.0f) * li) / den;
}
__device__ __forceinline__ void s5_apow(float lrdt, double rev, int e, float& wr, float& wi) {
    const float mag = __expf(lrdt * (float)e); double r = rev * (double)e; r -= __builtin_rint(r); const float rf = (float)r;
    wr = mag * __builtin_amdgcn_cosf(rf); wi = mag * __builtin_amdgcn_sinf(rf);
}

__device__ __forceinline__ void tr_item(const float* W, int N, int k0, int n0, bf16* WT, int ldt, int drow0, LAS float* scr, int lane) {
#pragma unroll 8
    for (int i = 0; i < 32; ++i) { const int kk = 2 * i + (lane >> 5); scr[kk * 33 + (lane & 31)] = W[(size_t)(k0 + kk) * N + n0 + (lane & 31)]; }
    LDS_WAIT(); asm volatile("" ::: "memory");
    const int c = lane & 7;
#pragma unroll
    for (int j = 0; j < 4; ++j) { const int n = (lane >> 3) + 8 * j; const LAS float* s = scr + (8 * c) * 33 + n;
        v4u o; o.x = pk2(s[0 * 33], s[1 * 33]); o.y = pk2(s[2 * 33], s[3 * 33]); o.z = pk2(s[4 * 33], s[5 * 33]); o.w = pk2(s[6 * 33], s[7 * 33]);
        *(v4u*)(WT + (size_t)(drow0 + n) * ldt + k0 + 8 * c) = o; }
    LDS_WAIT(); asm volatile("" ::: "memory");
}
__device__ __forceinline__ int glu_row(int n0, int Nh) { const int hh = n0 >= Nh ? 1 : 0, j = n0 - hh * Nh; return (j >> 7) * 256 + hh * 128 + (j & 127); }

typedef const __attribute__((address_space(4))) Args* ArgsP;
__device__ __forceinline__ ArgsP get_args() { ArgsP p = (ArgsP)__builtin_amdgcn_kernarg_segment_ptr(); asm volatile("" : "+s"(p)); return p; }
template <int ph> __device__ __forceinline__ void run_phase(unsigned char* lds_raw) {
    ArgsP ap = get_args();
    LAS unsigned char* lds = (LAS unsigned char*)lds_raw;
    const int tid = tid_fresh(), lane = tid & 63, wave = __builtin_amdgcn_readfirstlane(tid >> 6);
    const int G = gridDim.x, bx = blockIdx.x, vcu = (G % 8 == 0) ? (bx % 8) * (G / 8) + bx / 8 : bx;
    const int gw = vcu * NWAVES + wave, NGW = G * NWAVES;
    unsigned char* ws = ap->ws;
    float* MODS = (float*)(ws + WS_MODS); float* ROPE = (float*)(ws + WS_ROPE); float* KTAB = (float*)(ws + WS_KTAB);
    bf16* WGU1 = (bf16*)(ws + WS_WGU1); bf16* WD1 = (bf16*)(ws + WS_WD1); bf16* WGU2 = (bf16*)(ws + WS_WGU2); bf16* WD2 = (bf16*)(ws + WS_WD2);
    bf16* WIN = (bf16*)(ws + WS_WIN); bf16* WUQ = (bf16*)(ws + WS_WUQ); bf16* WUKV = (bf16*)(ws + WS_WUKV); bf16* WOUT = (bf16*)(ws + WS_WOUT); bf16* WGLU = (bf16*)(ws + WS_WGLU);
    bf16* BTY = (bf16*)(ws + WS_BTY); bf16* BTE = (bf16*)(ws + WS_BTE); bf16* AU = (bf16*)(ws + WS_AU); float* EB = (float*)(ws + WS_E);
    bf16* A = (bf16*)(ws + WS_A); float* X1C = (float*)(ws + WS_X1C); bf16* CQ = (bf16*)(ws + WS_CQ); bf16* CKV = (bf16*)(ws + WS_CKV);
    bf16* VF = (bf16*)(ws + WS_V); bf16* ZS = (bf16*)(ws + WS_ZS); bf16* H = (bf16*)(ws + WS_H); float* P = (float*)(ws + WS_P); bf16* QF = (bf16*)(ws + WS_Q); bf16* KF = (bf16*)(ws + WS_K);
    float* RS = (float*)(ws + WS_RS); float* SHWI = (float*)(ws + WS_SHWI); float* SHWG = (float*)(ws + WS_SHWG); bf16* A4 = (bf16*)(ws + WS_A4);
    float* X1 = ap->out;

        if constexpr (ph == 0) {
            LAS float* fl = (LAS float*)lds;
            {
                LAS float* sil = fl;
                LAS float* red = fl + 9 * 1024;
                for (int i = tid; i < 9 * 1024; i += NTHREADS) { const int r = i >> 10, k = i & 1023; const float c = r < NB ? ap->in[I_C][r * DM + k] : ap->in[I_CCTX][k]; sil[i] = c * pg8::sigmoidf_fast(c); }
                __syncthreads();
                const int cgp = tid & 7, kg = tid >> 3;
                for (int item = bx; item < NMODV / 32; item += G) {
                    const int j0 = item * 32 + cgp * 4;
                    f32x4 acc[9];
#pragma unroll
                    for (int r = 0; r < 9; ++r) acc[r] = (f32x4){0.f, 0.f, 0.f, 0.f};
#pragma unroll 4
                    for (int kk = 0; kk < 16; ++kk) { const int k = kg * 16 + kk; const f32x4 w = *(const f32x4*)(ap->in[I_WMOD] + (size_t)k * NMODV + j0);
#pragma unroll
                        for (int r = 0; r < 9; ++r) acc[r] += w * sil[r * 1024 + k]; }
#pragma unroll
                    for (int r = 0; r < 9; ++r) *(LAS f32x4*)(red + (kg * 9 + r) * 32 + cgp * 4) = acc[r];
                    __syncthreads();
                    if (tid < 9 * 32) { const int r = tid >> 5, c = tid & 31; float s = 0.f;
                        for (int q = 0; q < 64; ++q) s += red[(q * 9 + r) * 32 + c];
                        MODS[(size_t)r * NMODV + item * 32 + c] = s + ap->in[I_BMOD][item * 32 + c]; }
                    __syncthreads();
                }
            }
            {
                LAS float* Cr = fl; LAS float* Ci = fl + 1024; LAS float* Br = fl + 2048; LAS float* Bi = fl + 3072; LAS float* Wr = fl + 4096; LAS float* Wi = fl + 4160;
                for (int item = bx; item < 2 * SG * 8; item += G) {
                    const int d = item >> 7, g = (item >> 3) & 15, oct = item & 7;
                    __syncthreads();
                    for (int i = tid; i < 1024; i += NTHREADS) {
                        Cr[i] = ap->in[I_CRE][(size_t)(d * SG + g) * 1024 + i]; Ci[i] = ap->in[I_CIM][(size_t)(d * SG + g) * 1024 + i];
                        const int p = i >> 4; float lrdt, fr, fi; double rev; s5_par(ap->in[I_LAMRE], ap->in[I_LAMIM], ap->in[I_LOGDT], d, g, p, lrdt, rev, fr, fi);
                        const float br = ap->in[I_BRE][(size_t)(d * SG + g) * 1024 + i], bi = ap->in[I_BIM][(size_t)(d * SG + g) * 1024 + i];
                        Br[i] = fr * br - fi * bi; Bi[i] = fr * bi + fi * br; }
                    for (int tt = 0; tt < 8; ++tt) { const int tau = oct * 8 + tt;
                        __syncthreads();
                        if (tid < SP) { float lrdt, fr, fi; double rev; s5_par(ap->in[I_LAMRE], ap->in[I_LAMIM], ap->in[I_LOGDT], d, g, tid, lrdt, rev, fr, fi); float wr, wi; s5_apow(lrdt, rev, tau, wr, wi); Wr[tid] = wr; Wi[tid] = wi; }
                        __syncthreads();
                        if (tid < 256) { const int co = tid >> 4, ci = tid & 15; float s = 0.f;
                            for (int p = 0; p < SP; ++p) { const float cr = Cr[co * 64 + p], cim = Ci[co * 64 + p], wr = Wr[p], wi = Wi[p];
                                const float cwr = cr * wr - cim * wi, cwi = cr * wi + cim * wr; s += cwr * Br[p * 16 + ci] - cwi * Bi[p * 16 + ci]; }
                            KTAB[((size_t)(g * 2 + d) * CH + tau) * 256 + tid] = s; }
                    }
                }
                __syncthreads();
            }
            LAS float* scr = (LAS float*)(lds + wave * 16384);
            {
                const int I1 = (DM / 64) * (2 * DFF / 32), I2 = (DFF / 64) * (DM / 32), I3 = (DM / 64) * (672 / 32), I4 = (256 / 64) * (1152 / 32), I5 = (128 / 64) * (1536 / 32), I6 = (DM / 64) * (DM / 32), I7 = (256 / 64) * (512 / 32);
                const int NIT = 2 * I1 + 2 * I2 + I3 + I4 + I5 + I6 + I7;
                for (int it = gw; it < NIT; it += NGW) {
                    int r = it;
                    if (r < 2 * I1) { const int which = r >= I1; r -= which * I1; const int nblk = 2 * DFF / 32, kb = r / nblk, nb = r % nblk;
                        tr_item(ap->in[which ? I_WGU2 : I_WGU1], 2 * DFF, kb * 64, nb * 32, which ? WGU2 : WGU1, DM, glu_row(nb * 32, DFF) - 0, scr, lane); continue; } r -= 2 * I1;
                    if (r < 2 * I2) { const int which = r >= I2; r -= which * I2; const int nblk = DM / 32, kb = r / nblk, nb = r % nblk;
                        tr_item(ap->in[which ? I_WD2 : I_WD1], DM, kb * 64, nb * 32, which ? WD2 : WD1, DFF, nb * 32, scr, lane); continue; } r -= 2 * I2;
                    if (r < I3) { const int nblk = 672 / 32, kb = r / nblk, nb = r % nblk; tr_item(ap->in[I_WIN], 672, kb * 64, nb * 32, WIN, DM, nb * 32, scr, lane); continue; } r -= I3;
                    if (r < I4) { const int nblk = 1152 / 32, kb = r / nblk, nb = r % nblk; tr_item(ap->in[I_WUQ], 1152, kb * 64, nb * 32, WUQ, 256, nb * 32, scr, lane); continue; } r -= I4;
                    if (r < I5) { const int nblk = 1536 / 32, kb = r / nblk, nb = r % nblk; tr_item(ap->in[I_WUKV], 1536, kb * 64, nb * 32, WUKV, 256, nb * 32, scr, lane); continue; } r -= I5;
                    if (r < I6) { const int nblk = DM / 32, kb = r / nblk, nb = r % nblk; tr_item(ap->in[I_WOUT], DM, kb * 64, nb * 32, WOUT, DM, nb * 32, scr, lane); continue; } r -= I6;
                    { const int nblk = 512 / 32, kb = r / nblk, nb = r % nblk; tr_item(ap->in[I_WGLU], 512, kb * 64, nb * 32, WGLU, 256, glu_row(nb * 32, 256), scr, lane); }
                }
            }
            { const v4u z = {0u, 0u, 0u, 0u}; const int gt = vcu * NTHREADS + tid, NGT = G * NTHREADS;
              for (int i = gt; i < 96 * DM / 8; i += NGT) *(v4u*)(WIN + (size_t)672 * DM + (size_t)i * 8) = z;
              for (int i = gt; i < 128 * 256 / 8; i += NGT) *(v4u*)(WUQ + (size_t)1152 * 256 + (size_t)i * 8) = z;
              for (int i = gt; i < 1536 * 16; i += NGT) *(v4u*)(WUKV + (size_t)(i >> 4) * 256 + 128 + (i & 15) * 8) = z;
              for (int i = gt; i < SEQ * 16; i += NGT) { const int t = i >> 4, ii = i & 15; const float pos = (float)(ii < 8 ? (t >> 6) : (t & 63));
                  const float invf = exp2f(-(float)(ii & 7) * (13.287712379549449f / 8.0f)); const float ang = pos * invf;
                  double rv = (double)ang * 0.15915494309189535; rv -= __builtin_rint(rv); const float rf = (float)rv;
                  *(f32x2*)(ROPE + (size_t)i * 2) = (f32x2){__builtin_amdgcn_cosf(rf), __builtin_amdgcn_sinf(rf)}; }
            }
            for (int it = gw; it < SG * 2 * CH; it += NGW) { const int g = it >> 7, d = (it >> 6) & 1, t = it & 63, p = lane;
                float lrdt, fr, fi; double rev; s5_par(ap->in[I_LAMRE], ap->in[I_LAMIM], ap->in[I_LOGDT], d, g, p, lrdt, rev, fr, fi);
                float wr, wi; s5_apow(lrdt, rev, d == 0 ? t + 1 : CH - t, wr, wi);
#pragma unroll 4
                for (int co = 0; co < SC; ++co) { const float cr = ap->in[I_CRE][((size_t)(d * SG + g) * SC + co) * SP + p], cim = ap->in[I_CIM][((size_t)(d * SG + g) * SC + co) * SP + p];
                    const float re = cr * wr - cim * wi, im = cr * wi + cim * wr;
                    *(unsigned*)(BTY + ((size_t)g * 1024 + t * 16 + co) * AUK + 1024 + d * 128 + 2 * p) = pk2(re, -im); } }
            for (int it = gw; it < SG * 2 * SP; it += NGW) { const int g = it >> 7, d = (it >> 6) & 1, p = it & 63, s = lane;
                float lrdt, fr, fi; double rev; s5_par(ap->in[I_LAMRE], ap->in[I_LAMIM], ap->in[I_LOGDT], d, g, p, lrdt, rev, fr, fi);
                float wr, wi; s5_apow(lrdt, rev, d == 0 ? CH - 1 - s : s, wr, wi);
                float ore[16], oim[16];
#pragma unroll
                for (int ci = 0; ci < SC; ++ci) { const float br = ap->in[I_BRE][((size_t)(d * SG + g) * SP + p) * SC + ci], bi = ap->in[I_BIM][((size_t)(d * SG + g) * SP + p) * SC + ci];
                    const float bbr = fr * br - fi * bi, bbi = fr * bi + fi * br; ore[ci] = wr * bbr - wi * bbi; oim[ci] = wr * bbi + wi * bbr; }
                bf16* r0 = BTE + ((size_t)g * 256 + d * 128 + 2 * p) * 1024 + s * 16; bf16* r1 = r0 + 1024;
                v4u a, b2; a.x = pk2(ore[0], ore[1]); a.y = pk2(ore[2], ore[3]); a.z = pk2(ore[4], ore[5]); a.w = pk2(ore[6], ore[7]); b2.x = pk2(ore[8], ore[9]); b2.y = pk2(ore[10], ore[11]); b2.z = pk2(ore[12], ore[13]); b2.w = pk2(ore[14], ore[15]);
                *(v4u*)r0 = a; *(v4u*)(r0 + 8) = b2;
                a.x = pk2(oim[0], oim[1]); a.y = pk2(oim[2], oim[3]); a.z = pk2(oim[4], oim[5]); a.w = pk2(oim[6], oim[7]); b2.x = pk2(oim[8], oim[9]); b2.y = pk2(oim[10], oim[11]); b2.z = pk2(oim[12], oim[13]); b2.w = pk2(oim[14], oim[15]);
                *(v4u*)r1 = a; *(v4u*)(r1 + 8) = b2; }
        }
        if constexpr (ph == 1) {
            const int gi = I_GFFN1, msh = 0;
            const float* gvec = ap->in[gi];
            const int nrows = MT;
            for (int r = gw; r < nrows; r += NGW) {
                const bool isc = r >= NLAT; const int mrow = isc ? NB : (r >> 12);
                const float* src = ph == 1 ? (isc ? ap->in[I_CTX] + (size_t)(r - NLAT) * DM : ap->in[I_X] + (size_t)r * DM) : (isc ? X1C + (size_t)(r - NLAT) * DM : X1 + (size_t)r * DM);
                const float* shift = MODS + (size_t)mrow * NMODV + msh * DM; const float* scale = shift + DM;
                f32x4 v[4]; float s = 0.f;
#pragma unroll
                for (int j = 0; j < 4; ++j) { v[j] = *(const f32x4*)(src + 4 * lane + 256 * j); s += (v[j].x * v[j].x + v[j].y * v[j].y) + (v[j].z * v[j].z + v[j].w * v[j].w); }
                const float rinv = 1.0f / sqrtf(wave_sum(s) * (1.0f / DM) + EPS);
#pragma unroll
                for (int j = 0; j < 4; ++j) { const int c = 4 * lane + 256 * j; const f32x4 gg = *(const f32x4*)(gvec + c), sc = *(const f32x4*)(scale + c), sh = *(const f32x4*)(shift + c);
                    const f32x4 y = v[j] * rinv * gg * (sc + 1.0f) + sh; v2u o; o.x = pk2(y.x, y.y); o.y = pk2(y.z, y.w); *(v2u*)(A + (size_t)r * DM + c) = o; }
            }
            if (ph == 1) {
                for (int it = gw; it < SG * CH * SC; it += NGW) { const int g = it >> 10, t = (it >> 4) & 63, co = it & 15, s = lane;
                    float v[16];
#pragma unroll
                    for (int ci = 0; ci < 16; ++ci) v[ci] = 0.f;
                    if (s <= t) { const float* k0 = KTAB + ((size_t)(g * 2 + 0) * CH + (t - s)) * 256 + co * 16;
#pragma unroll
                        for (int q = 0; q < 4; ++q) { const f32x4 x = *(const f32x4*)(k0 + 4 * q); v[4 * q] += x.x; v[4 * q + 1] += x.y; v[4 * q + 2] += x.z; v[4 * q + 3] += x.w; } }
                    if (s >= t) { const float* k1 = KTAB + ((size_t)(g * 2 + 1) * CH + (s - t)) * 256 + co * 16;
#pragma unroll
                        for (int q = 0; q < 4; ++q) { const f32x4 x = *(const f32x4*)(k1 + 4 * q); v[4 * q] += x.x; v[4 * q + 1] += x.y; v[4 * q + 2] += x.z; v[4 * q + 3] += x.w; } }
                    if (s == t) { const float dsk = ap->in[I_DSKIP][g * 16 + co];
#pragma unroll
                        for (int ci = 0; ci < 16; ++ci) v[ci] += (ci == co) ? dsk : 0.f; }
                    bf16* dst = BTY + ((size_t)g * 1024 + t * 16 + co) * AUK + s * 16;
                    v4u a, b2; a.x = pk2(v[0], v[1]); a.y = pk2(v[2], v[3]); a.z = pk2(v[4], v[5]); a.w = pk2(v[6], v[7]); b2.x = pk2(v[8], v[9]); b2.y = pk2(v[10], v[11]); b2.z = pk2(v[12], v[13]); b2.w = pk2(v[14], v[15]);
                    *(v4u*)dst = a; *(v4u*)(dst + 8) = b2; }
                for (int it = gw; it < DINP + 2 * DFF; it += NGW) { const bool isw = it < DINP; const int n = isw ? it : it - DINP; const bf16* wrow = (isw ? WIN : WGU2) + (size_t)n * DM + 16 * lane;
                    const v4u w0 = *(const v4u*)wrow, w1 = *(const v4u*)(wrow + 8); const unsigned ww[8] = {w0.x, w0.y, w0.z, w0.w, w1.x, w1.y, w1.z, w1.w}; float wf[16];
#pragma unroll
                    for (int q = 0; q < 8; ++q) { wf[2 * q] = __builtin_bit_cast(float, ww[q] << 16); wf[2 * q + 1] = __builtin_bit_cast(float, ww[q] & 0xffff0000u); }
                    float res = 0.f;
                    for (int r = 0; r < 9; ++r) { const float* sh = MODS + (size_t)r * NMODV + (isw ? 3 : 6) * DM + 16 * lane; float d = 0.f;
#pragma unroll
                        for (int q = 0; q < 4; ++q) { const f32x4 x = *(const f32x4*)(sh + 4 * q); d += (x.x * wf[4 * q] + x.y * wf[4 * q + 1]) + (x.z * wf[4 * q + 2] + x.w * wf[4 * q + 3]); }
                        d = wave_sum(d); if (lane == r) res = d; }
                    if (lane < 9) (isw ? SHWI + (size_t)lane * DINP : SHWG + (size_t)lane * (2 * DFF))[n] = res; }
            }
        }
        if constexpr (ph == 2 || ph == 14) {
            const int M = ph == 2 ? MT : NLAT;
            pg8::Gemm g{ph == 2 ? A : A4, ph == 2 ? WGU1 : WGU2, DM, DM, DM}; pg8::StaticOrder S; S.init(M, 2 * DFF, G, bx);
            pg8::EpiSwiGLU<ph == 14> E{H, DFF, RS, SHWG};
            pg8::gemm_phase<pg8::EpiSwiGLU<ph == 14>, pg8::StaticOrder, true>(lds, g, S, E);
        }
        if constexpr (ph == 3 || ph == 12 || ph == 15) {
            const int M = ph == 3 ? MT : NLAT;
            pg8::Gemm g{ph == 12 ? A : H, ph == 3 ? WD1 : ph == 12 ? WOUT : WD2, ph == 12 ? DM : DFF, ph == 12 ? DM : DFF, ph == 12 ? DM : DFF};
            pg8::StaticOrder S; S.init(M, DM, G, bx);
            constexpr bool MODE = (ph != 15);
            pg8::EpiResid<MODE> E{ph == 3 ? ap->in[I_X] : X1, X1, ap->in[I_CTX], X1C, MODS + (ph == 3 ? 2 : ph == 12 ? 5 : 8) * DM,
                                  ap->in[ph == 3 ? I_GMIX : I_GFFN2], MODS + (ph == 3 ? 4 : 7) * DM, ph == 3 ? A : A4, RS, ph == 12 ? 1.0f : 0.5f};
            pg8::gemm_phase<pg8::EpiResid<MODE>, pg8::StaticOrder, true>(lds, g, S, E);
        }
        if constexpr (ph == 5) {
            pg8::Gemm g{A, WIN, DM, DM, DM}; pg8::StaticOrder S; S.init(MT, DINP, G, bx);
            pg8::EpiF32<true> E{P, DINP, 0, RS, SHWI};
            pg8::gemm_phase<pg8::EpiF32<true>, pg8::StaticOrder, true>(lds, g, S, E);
        }
        if constexpr (ph == 6) {
            for (int r = gw; r < MT; r += NGW) {
                const float* pr = P + (size_t)r * DINP; const bool isc = r >= NLAT;
                int b, t, key; if (isc) { const int q = r - NLAT; b = q >> 8; t = q & 255; key = t; } else { b = r >> 12; t = r & (SEQ - 1); key = CTXL + t; }
                if (!isc) { const f32x4 v = *(const f32x4*)(pr + 4 * lane); const float s = wave_sum((v.x * v.x + v.y * v.y) + (v.z * v.z + v.w * v.w));
                    const float rinv = 1.0f / sqrtf(s * (1.0f / 256.0f) + EPS); const f32x4 gq = *(const f32x4*)(ap->in[I_GCQ] + 4 * lane); const f32x4 y = v * rinv * gq;
                    v2u o; o.x = pk2(y.x, y.y); o.y = pk2(y.z, y.w); *(v2u*)(CQ + (size_t)r * 256 + 4 * lane) = o; }
                { const f32x2 v = *(const f32x2*)(pr + 256 + 2 * lane); const float s = wave_sum(v.x * v.x + v.y * v.y); const float rinv = 1.0f / sqrtf(s * (1.0f / 128.0f) + EPS);
                  const f32x2 gk = *(const f32x2*)(ap->in[I_GCKV] + 2 * lane); *(unsigned*)(CKV + (size_t)r * 256 + 2 * lane) = pk2(v.x * rinv * gk.x, v.y * rinv * gk.y);
                  *(unsigned*)(CKV + (size_t)r * 256 + 128 + 2 * lane) = 0u; }
                { const int i = lane & 15; const f32x2 v = *(const f32x2*)(pr + 384 + 2 * i); float o1 = v.x, o2 = v.y;
                  if (!isc) { const f32x2 cs = *(const f32x2*)(ROPE + ((size_t)t * 16 + i) * 2); o1 = v.x * cs.x - v.y * cs.y; o2 = v.x * cs.y + v.y * cs.x; }
                  const unsigned w = pk2(o1, o2);
#pragma unroll
                  for (int j = 0; j < 3; ++j) { const int h = (lane >> 4) + 4 * j; *(unsigned*)(KF + ((size_t)(b * NH + h) * SKV + key) * DQK + 64 + 2 * i) = w; } }
                { const f32x4 v = *(const f32x4*)(pr + 416 + 4 * lane); const int g = lane >> 2, ci0 = (lane & 3) * 4;
                  const int rowl = isc ? 512 + b * 4 + (t >> 6) : b * 64 + (t >> 6); const int s = t & 63;
                  v2u o; o.x = pk2(v.x, v.y); o.y = pk2(v.z, v.w); *(v2u*)(AU + ((size_t)g * AUR + rowl) * AUK + s * 16 + ci0) = o; }
            }
        }
        if constexpr (ph == 7) {
            { pg8::Gemm g{CQ, WUQ, 256, 256, 256}; pg8::StaticOrder S; S.init(NLAT, 1280, G, bx); pg8::EpiQ E{QF, ROPE};
              pg8::gemm_phase<pg8::EpiQ, pg8::StaticOrder, true>(lds, g, S, E); }
            { pg8::Gemm g{CKV, WUKV, 256, 256, 256}; pg8::StaticOrder S; S.init(MT, 1536, G, bx); pg8::EpiKV E{KF, VF};
              pg8::gemm_phase<pg8::EpiKV, pg8::StaticOrder, true>(lds, g, S, E); }
            { pg8::Gemm g{AU, BTE, 1024, AUK, 1024}; pg8::OrderE S{G, bx}; pg8::EpiF32<false> E{EB, 256, 1, nullptr, nullptr};
              pg8::gemm_phase<pg8::EpiF32<false>, pg8::OrderE, true>(lds, g, S, E); }
        }
        if constexpr (ph == 8) {
            { const int ci = vcu * NTHREADS + tid;
              if (ci < NB * SG * 2 * SP) { const int p = ci & 63, d = (ci >> 6) & 1, g = (ci >> 7) & 15, b = ci >> 11;
                float lrdt, fr, fi; double rev; s5_par(ap->in[I_LAMRE], ap->in[I_LAMIM], ap->in[I_LOGDT], d, g, p, lrdt, rev, fr, fi);
                float ar, ai; s5_apow(lrdt, rev, CH, ar, ai);
                const float* Eg = EB + (size_t)g * AUR * 256 + d * 128 + 2 * p; bf16* Xg = AU + (size_t)g * AUR * AUK + 1024 + d * 128 + 2 * p;
                float xr = 0.f, xi = 0.f;
                for (int kc = 0; kc < 4; ++kc) { const int c = d == 0 ? kc : 3 - kc; const f32x2 e = *(const f32x2*)(Eg + (size_t)(512 + b * 4 + c) * 256);
                    const float nr = ar * xr - ai * xi + e.x, ni = ar * xi + ai * xr + e.y; xr = nr; xi = ni; }
#pragma unroll 8
                for (int k = 0; k < 64; ++k) { const int c = d == 0 ? k : 63 - k; const f32x2 e = *(const f32x2*)(Eg + (size_t)(b * 64 + c) * 256);
                    *(unsigned*)(Xg + (size_t)(b * 64 + c) * AUK) = pk2(xr, xi);
                    const float nr = ar * xr - ai * xi + e.x, ni = ar * xi + ai * xr + e.y; xr = nr; xi = ni; }
              } }
            for (int i = 0; ; ++i) { const int u = i * G + vcu; if (u >= NB * NH * (SEQ / 256)) break; const int bh = u >> 4, qb = u & 15, b = bh / NH, h = bh - b * NH;
                att::attn_unit(QF + ((size_t)bh * SEQ + qb * 256) * DQK, KF + (size_t)bh * SKV * DQK, VF + (size_t)bh * SKV * DV, A + ((size_t)b * SEQ + qb * 256) * DM + h * DV, DM, (char*)lds_raw); }
        }
        if constexpr (ph == 9) {
            pg8::Gemm g{AU, BTY, AUK, AUK, AUK}; pg8::OrderY S{G, bx}; pg8::EpiY E{ZS};
            pg8::gemm_phase<pg8::EpiY, pg8::OrderY, true>(lds, g, S, E);
        }
        if constexpr (ph == 10) {
            pg8::Gemm g{ZS, WGLU, 256, 256, 256}; pg8::StaticOrder S; S.init(NLAT, 512, G, bx); pg8::EpiGLU E{A, DM, 768};
            pg8::gemm_phase<pg8::EpiGLU, pg8::StaticOrder, true>(lds, g, S, E);
        }
        if constexpr (ph == 11) {
            for (int r = gw; r < NLAT; r += NGW) {
                bf16* row = A + (size_t)r * DM + 16 * lane; v4u w0 = *(const v4u*)row, w1 = *(const v4u*)(row + 8);
                float x[16]; const unsigned ww[8] = {w0.x, w0.y, w0.z, w0.w, w1.x, w1.y, w1.z, w1.w};
#pragma unroll
                for (int q = 0; q < 8; ++q) { x[2 * q] = __builtin_bit_cast(float, ww[q] << 16); x[2 * q + 1] = __builtin_bit_cast(float, ww[q] & 0xffff0000u); }
                float s = 0.f;
#pragma unroll
                for (int q = 0; q < 16; ++q) s += x[q] * x[q];
                const bool isa = lane < 48; const float sa = wave_sum(isa ? s : 0.f), ss = wave_sum(isa ? 0.f : s);
                const float rinv = isa ? 1.0f / sqrtf(sa * (1.0f / 768.0f) + EPS) : 1.0f / sqrtf(ss * (1.0f / 256.0f) + EPS);
                const float* gp = isa ? ap->in[I_GMLA] + 16 * lane : ap->in[I_GSSM] + 16 * (lane - 48);
                unsigned o[8];
#pragma unroll
                for (int q = 0; q < 4; ++q) { const f32x4 gg = *(const f32x4*)(gp + 4 * q); o[2 * q] = pk2(x[4 * q] * rinv * gg.x, x[4 * q + 1] * rinv * gg.y); o[2 * q + 1] = pk2(x[4 * q + 2] * rinv * gg.z, x[4 * q + 3] * rinv * gg.w); }
                *(v4u*)row = (v4u){o[0], o[1], o[2], o[3]}; *(v4u*)(row + 8) = (v4u){o[4], o[5], o[6], o[7]};
            }
        }
        if constexpr (ph == 16) {
            const float* gvec = ap->in[I_GFINAL];
            for (int r = gw; r < NLAT; r += NGW) {
                float* src = X1 + (size_t)r * DM; f32x4 v[4]; float s = 0.f;
#pragma unroll
                for (int j = 0; j < 4; ++j) { v[j] = *(const f32x4*)(src + 4 * lane + 256 * j); s += (v[j].x * v[j].x + v[j].y * v[j].y) + (v[j].z * v[j].z + v[j].w * v[j].w); }
                const float rinv = 1.0f / sqrtf(wave_sum(s) * (1.0f / DM) + EPS);
#pragma unroll
                for (int j = 0; j < 4; ++j) { const int c = 4 * lane + 256 * j; const f32x4 gg = *(const f32x4*)(gvec + c); *(f32x4*)(src + c) = v[j] * rinv * gg; }
            }
        }
}


template <int ph> __global__ void __launch_bounds__(NTHREADS, 2) fwd_ph(Args args) {
    extern __shared__ __attribute__((aligned(16))) unsigned char lds_raw[];
    run_phase<ph>(lds_raw);
}
#if MK_ONE_LAUNCH
__global__ void __launch_bounds__(NTHREADS, 2) fwd_all(Args args) {
    extern __shared__ __attribute__((aligned(16))) unsigned char lds_raw[];
    LAS unsigned char* lds = (LAS unsigned char*)lds_raw;
    const int tid = threadIdx.x;
    for (int u = tid; u < (LDS_BYTES - LDSCTL_OFF) / 4; u += NTHREADS) ((LAS unsigned*)(lds + LDSCTL_OFF))[u] = 0u;
    __syncthreads();
    XcdBarrier bar = xcd_barrier_post((unsigned*)(get_args()->ws + WS_CTL) + 4096, (volatile LAS unsigned*)(lds + LDSCTL_OFF + 64));
    run_phase<0>(lds_raw); cg::this_grid().sync();
    run_phase<1>(lds_raw); if (PROBE_DUP == 1) { xcd_barrier(bar); run_phase<1>(lds_raw); } xcd_barrier(bar);
    run_phase<2>(lds_raw); if (PROBE_DUP == 2) { xcd_barrier(bar); run_phase<2>(lds_raw); } xcd_barrier(bar);
    run_phase<3>(lds_raw); if (PROBE_DUP == 3) { xcd_barrier(bar); run_phase<3>(lds_raw); } xcd_barrier(bar);
    run_phase<5>(lds_raw); if (PROBE_DUP == 5) { xcd_barrier(bar); run_phase<5>(lds_raw); } xcd_barrier(bar);
    run_phase<6>(lds_raw); if (PROBE_DUP == 6) { xcd_barrier(bar); run_phase<6>(lds_raw); } xcd_barrier(bar);
    run_phase<7>(lds_raw); if (PROBE_DUP == 7) { xcd_barrier(bar); run_phase<7>(lds_raw); } xcd_barrier(bar);
    run_phase<8>(lds_raw); if (PROBE_DUP == 8) { xcd_barrier(bar); run_phase<8>(lds_raw); } xcd_barrier(bar);
    run_phase<9>(lds_raw); if (PROBE_DUP == 9) { xcd_barrier(bar); run_phase<9>(lds_raw); } xcd_barrier(bar);
    run_phase<10>(lds_raw); if (PROBE_DUP == 10) { xcd_barrier(bar); run_phase<10>(lds_raw); } xcd_barrier(bar);
    run_phase<11>(lds_raw); if (PROBE_DUP == 11) { xcd_barrier(bar); run_phase<11>(lds_raw); } xcd_barrier(bar);
    run_phase<12>(lds_raw); if (PROBE_DUP == 12) { xcd_barrier(bar); run_phase<12>(lds_raw); } xcd_barrier(bar);
    run_phase<14>(lds_raw); if (PROBE_DUP == 14) { xcd_barrier(bar); run_phase<14>(lds_raw); } xcd_barrier(bar);
    run_phase<15>(lds_raw); if (PROBE_DUP == 15) { xcd_barrier(bar); run_phase<15>(lds_raw); } xcd_barrier(bar);
    run_phase<16>(lds_raw);
}
#endif

#include <utility>
#if MK_ONE_LAUNCH
#define KFUNC ((const void*)fwd_all)
static bool set_lds_attr() { return hipFuncSetAttribute((const void*)fwd_all, hipFuncAttributeMaxDynamicSharedMemorySize, LDS_BYTES) == hipSuccess; }
#else
#define KFUNC ((const void*)fwd_ph<2>)
template <int... P> static bool set_lds_attr_seq(std::integer_sequence<int, P...>) { bool ok = true; ((ok = ok && hipFuncSetAttribute((const void*)fwd_ph<P>, hipFuncAttributeMaxDynamicSharedMemorySize, LDS_BYTES) == hipSuccess), ...); return ok; }
static bool set_lds_attr() { return set_lds_attr_seq(std::make_integer_sequence<int, NPHASES>{}); }
template <int P> static void launch_one(const Args& a, int grid, hipStream_t stream) { fwd_ph<P><<<dim3(grid), dim3(NTHREADS), LDS_BYTES, stream>>>(a); }
template <int... P> static void launch_all_phases(const Args& a, int grid, hipStream_t stream, std::integer_sequence<int, P...>) { (launch_one<P>(a, grid, stream), ...); }
#endif
extern "C" void kernel_launch(void* const* d_in, const int* in_sizes, int n_in, void* d_out, int out_size, void* d_ws, size_t ws_size, hipStream_t stream) {
    static int grid = 0;
    if (grid == 0) {
        if (n_in != 31 || out_size != NLAT * DM || ws_size < WS_END) { fprintf(stderr, "kernel_launch: unexpected shapes n_in %d out %d ws %zu (need %zu)\n", n_in, out_size, ws_size, (size_t)WS_END); grid = -1; return; }
        int dev = 0, cus = 0, per_cu = 0;
        if (hipGetDevice(&dev) != hipSuccess || hipDeviceGetAttribute(&cus, hipDeviceAttributeMultiprocessorCount, dev) != hipSuccess) { grid = -1; return; }
        if (!set_lds_attr()) { fprintf(stderr, "kernel_launch: hipFuncSetAttribute failed\n"); grid = -1; return; }
        if (hipOccupancyMaxActiveBlocksPerMultiprocessor(&per_cu, KFUNC, NTHREADS, LDS_BYTES) != hipSuccess || per_cu < 1) { fprintf(stderr, "kernel_launch: occupancy query says %d\n", per_cu); per_cu = 1; }
        (void)hipGetLastError();
        grid = cus;
    }
    if (grid < 0) return;
    (void)hipMemsetAsync((char*)d_ws + WS_CTL, 0, CTL_BYTES, stream);
    Args a{};
    for (int i = 0; i < 31; ++i) a.in[i] = (const float*)d_in[i];
    a.out = (float*)d_out; a.ws = (unsigned char*)d_ws;
#if MK_ONE_LAUNCH
    a.ph_lo = 0; a.ph_hi = NPHASES; a.use_bar = 1;
    void* kargs[] = {&a};
    hipError_t e = hipLaunchCooperativeKernel((const void*)fwd_all, dim3(grid), dim3(NTHREADS), kargs, LDS_BYTES, stream);
    if (e != hipSuccess) fprintf(stderr, "kernel_launch: cooperative launch failed: %s (grid %d)\n", hipGetErrorString(e), grid);
#else
    a.ph_lo = 0; a.ph_hi = 1; a.use_bar = 0;
    launch_all_phases(a, grid, stream, std::make_integer_sequence<int, NPHASES>{});
    const hipError_t le = hipPeekAtLastError();
    if (le != hipSuccess) fprintf(stderr, "kernel_launch: launch failed: %s\n", hipGetErrorName(le));
#endif
}
```

```cpp
#include <hip/hip_runtime.h>
#include <hip/hip_cooperative_groups.h>
#include <cstdio>
#include <cstdint>
namespace cg = cooperative_groups;

#ifndef MK_ONE_LAUNCH
#define MK_ONE_LAUNCH 1
#endif
#ifndef PROBE_DUP
#define PROBE_DUP -1
#endif

constexpr int DM = 1024, NB = 8, SEQ = 4096, CTXL = 256, NLAT = NB * SEQ, NCTX = NB * CTXL, MT = NLAT + NCTX;
constexpr int DFF = 2816, NMODV = 9 * DM;
constexpr int NH = 12, DQK = 96, DV = 64, SKV = CTXL + SEQ;
constexpr int DINP = 768;
constexpr float EPS = 1e-6f;
constexpr float QSCALE = 0.10206207261596577f * 1.4426950408889634f;
constexpr int SG = 16, SC = 16, SP = 64, CH = 64;
constexpr int AUR = 768, AUK = 1280;

__device__ __forceinline__ int tid_fresh() { int t = threadIdx.x; asm volatile("" : "+v"(t)); return t; }
namespace pg8 {
#define PG8_LAS __attribute__((address_space(3)))
typedef unsigned short bf16_t;
typedef short bf16x8 __attribute__((ext_vector_type(8)));
typedef float f32x4 __attribute__((ext_vector_type(4)));
typedef float f32x2 __attribute__((ext_vector_type(2)));
typedef unsigned u32x4 __attribute__((ext_vector_type(4)));
constexpr int BM = 256, BK = 64, HALF = 128, HTB = HALF * BK * 2, STAGE_BYTES = 8 * HTB, NXCD = 8, WGM = 8;
__host__ __device__ __forceinline__ int lds_byte(int r, int c) { const int st = (r >> 4) * 2 + (c >> 5), rr = r & 15, cc = c & 31, ob = rr * 64 + cc * 2; return st * 1024 + (ob ^ (((ob >> 9) & 1) << 5)); }
__host__ __device__ __forceinline__ void stage_rc(int b, int& R, int& C) { const int st = b / 1024, sb = b % 1024, swz = sb ^ (((sb >> 9) & 1) << 5); R = (st >> 1) * 16 + swz / 64; C = (st & 1) * 32 + (swz % 64) / 2; }
__host__ __device__ __forceinline__ int perm32(int rho) { const int n = rho >> 4, i = rho & 15; return 8 * (i >> 2) + 4 * n + (i & 3); }
struct Unit { int pm, pn; };
struct Gemm { const bf16_t* A; const bf16_t* Bt; int K, lda, ldb; };
struct StaticOrder {
    int nM, nN, nwg, G, c;
    __device__ void init(int M, int N, int G_, int c_) { nM = M / BM; nN = N / BM; nwg = nM * nN; G = G_; c = c_; }
    __device__ bool next(int i, Unit& u) const {
        const long L = (long)i * G + c; if (L >= nwg) return false;
        int wgid = (int)L; { const int q = nwg / NXCD, r = nwg % NXCD, xcd = wgid % NXCD, off = wgid / NXCD; wgid = (xcd < r ? xcd * (q + 1) : r * (q + 1) + (xcd - r) * q) + off; }
        const int nig = WGM * nN, gid = wgid / nig, fm = gid * WGM, gsz = (nM - fm) < WGM ? (nM - fm) : WGM;
        u.pm = fm + ((wgid % nig) % gsz); u.pn = (wgid % nig) / gsz; return true;
    }
};
struct OrderE { int G, c; __device__ bool next(int i, Unit& u) const { const int L = i * G + c; if (L >= SG * 3) return false; const int g = L / 3; u.pm = 3 * g + L % 3; u.pn = g; return true; } };
struct OrderY { int G, c; __device__ bool next(int i, Unit& u) const { const int L = i * G + c; if (L >= SG * 8) return false; const int g = L >> 3, r = L & 7; u.pm = 3 * g + (r >> 2); u.pn = 4 * g + (r & 3); return true; } };

__device__ __forceinline__ unsigned cvt_pk_bf16(float lo, float hi) { unsigned r; asm volatile("v_cvt_pk_bf16_f32 %0, %1, %2" : "=v"(r) : "v"(lo), "v"(hi)); return r; }

template <class Epi, class Sched, bool ALIGN_EPI>
__device__ __forceinline__ void gemm_phase(PG8_LAS unsigned char* lds, const Gemm g, const Sched& S, const Epi& E) {
    const int tid = tid_fresh(), wid = __builtin_amdgcn_readfirstlane(tid >> 6), lane = tid & 63, wr = wid >> 2, wc = wid & 3, fr = lane & 15, fq = lane >> 4;
    int K_ = g.K; asm volatile("" : "+s"(K_));
    const int K = K_, nt = K / BK;
    unsigned voffA[2], voffB[2];
#pragma unroll
    for (int i = 0; i < 2; ++i) { int R, C; stage_rc(tid * 16 + i * 8192, R, C); const int Rb = Epi::PERM ? ((R & ~31) + perm32(R & 31)) : R;
        voffA[i] = (unsigned)(R * g.lda + C) * 2u; voffB[i] = (unsigned)(Rb * g.ldb + C) * 2u; }
    const size_t kstep = (size_t)(BK * 2);
    const size_t hA = (size_t)HALF * g.lda * 2, hB = (size_t)HALF * g.ldb * 2, tA = 2 * hA, tB = 2 * hB;
    const unsigned ldsw = (unsigned)wid * 1024u;
    const int aoff = lds_byte(wr * 64 + fr, fq * 8), boff = lds_byte(wc * 32 + fr, fq * 8);
#define PG8_SA(b, h) (((b) * 2 + (h)) * HTB)
#define PG8_SB(b, h) ((4 + (b) * 2 + (h)) * HTB)
#define PG8_STAGE(bufoff, gbase, voff) do { _Pragma("unroll") for (int _i = 0; _i < 2; ++_i) \
        __builtin_amdgcn_global_load_lds((const unsigned*)((const char*)(gbase) + (voff)[_i]), (PG8_LAS unsigned*)(lds + (bufoff) + ldsw + _i * 8192), 16, 0, 0); } while (0)
#define PG8_LDA(dst, b, h) do { _Pragma("unroll") for (int m = 0; m < 4; ++m) _Pragma("unroll") for (int k = 0; k < 2; ++k) dst[m][k] = *(const PG8_LAS bf16x8*)(lds + PG8_SA(b, h) + aoff + m * 2048 + k * 1024); } while (0)
#define PG8_LDB(dst, b, h) do { _Pragma("unroll") for (int n = 0; n < 2; ++n) _Pragma("unroll") for (int k = 0; k < 2; ++k) dst[n][k] = *(const PG8_LAS bf16x8*)(lds + PG8_SB(b, h) + boff + n * 2048 + k * 1024); } while (0)
#define PG8_MMA(ai, bj, At, Bt) do { __builtin_amdgcn_s_setprio(1); _Pragma("unroll") for (int m = 0; m < 4; ++m) _Pragma("unroll") for (int n = 0; n < 2; ++n) _Pragma("unroll") for (int k = 0; k < 2; ++k) \
        acc[ai][bj][m][n] = __builtin_amdgcn_mfma_f32_16x16x32_bf16(Bt[n][k], At[m][k], acc[ai][bj][m][n], 0, 0, 0); __builtin_amdgcn_s_setprio(0); } while (0)
#define PG8_WAIT_V(n) asm volatile("s_waitcnt vmcnt(" #n ")" ::: "memory")
#define PG8_WAIT_L(n) asm volatile("s_waitcnt lgkmcnt(" #n ")" ::: "memory")
#define PG8_BAR __builtin_amdgcn_s_barrier()
#define PG8_SCHED __builtin_amdgcn_sched_barrier(0)
    Unit cur, nxt; int ui = 0;
    if (!S.next(0, cur)) return;
    f32x4 acc[2][2][4][2];
#pragma unroll
    for (int a = 0; a < 2; ++a)
#pragma unroll
        for (int b = 0; b < 2; ++b)
#pragma unroll
            for (int m = 0; m < 4; ++m)
#pragma unroll
                for (int n = 0; n < 2; ++n) acc[a][b][m][n] = (f32x4){0.f, 0.f, 0.f, 0.f};
    bf16x8 At[4][2], B0[2][2], B1[2][2];
    const char* cA = (const char*)g.A + (size_t)cur.pm * tA; const char* cB = (const char*)g.Bt + (size_t)cur.pn * tB;
    PG8_STAGE(PG8_SB(0, 0), cB, voffB); PG8_STAGE(PG8_SB(0, 1), cB + hB, voffB); PG8_STAGE(PG8_SA(0, 0), cA, voffA); PG8_STAGE(PG8_SA(0, 1), cA + hA, voffA);
    if (wr == 1) PG8_BAR;
    PG8_WAIT_V(2); PG8_BAR;
    PG8_STAGE(PG8_SB(1, 0), cB + kstep, voffB); PG8_STAGE(PG8_SA(1, 0), cA + kstep, voffA); PG8_STAGE(PG8_SB(1, 1), cB + hB + kstep, voffB);
    PG8_WAIT_V(6); PG8_BAR;
    for (;;) {
        const bool has_next = S.next(ui + 1, nxt);
        const char* nA = has_next ? (const char*)g.A + (size_t)nxt.pm * tA : cA; const char* nB = has_next ? (const char*)g.Bt + (size_t)nxt.pn * tB : cB;
        for (int t = 0; t < nt; t += 2) {
            const bool last = (t == nt - 2);
            const char* a1 = cA + (size_t)(t + 1) * kstep;
            const char* a2 = last ? nA : cA + (size_t)(t + 2) * kstep; const char* b2 = last ? nB : cB + (size_t)(t + 2) * kstep;
            const char* a3 = a2 + kstep; const char* b3 = b2 + kstep;
            PG8_LDB(B0, 0, 0); PG8_LDB(B1, 0, 1); PG8_SCHED; PG8_LDA(At, 0, 0); PG8_STAGE(PG8_SA(1, 1), a1 + hA, voffA);
            PG8_WAIT_V(8); PG8_WAIT_L(0); PG8_BAR; PG8_MMA(0, 0, At, B0); PG8_MMA(0, 1, At, B1); PG8_BAR; PG8_SCHED;
            PG8_LDA(At, 0, 1); PG8_STAGE(PG8_SB(0, 0), b2, voffB); PG8_STAGE(PG8_SB(0, 1), b2 + hB, voffB); PG8_STAGE(PG8_SA(0, 0), a2, voffA);
            PG8_WAIT_V(8); PG8_WAIT_L(0); PG8_BAR; PG8_MMA(1, 0, At, B0); PG8_MMA(1, 1, At, B1); PG8_BAR; PG8_SCHED;
            PG8_LDB(B0, 1, 0); PG8_LDB(B1, 1, 1); PG8_SCHED; PG8_LDA(At, 1, 0); PG8_STAGE(PG8_SA(0, 1), a2 + hA, voffA);
            PG8_WAIT_V(8); PG8_WAIT_L(0); PG8_BAR; PG8_MMA(0, 0, At, B0); PG8_MMA(0, 1, At, B1); PG8_BAR; PG8_SCHED;
            PG8_LDA(At, 1, 1); PG8_STAGE(PG8_SB(1, 0), b3, voffB); PG8_STAGE(PG8_SB(1, 1), b3 + hB, voffB); PG8_STAGE(PG8_SA(1, 0), a3, voffA);
            PG8_WAIT_V(8); PG8_WAIT_L(0); PG8_BAR; PG8_MMA(1, 0, At, B0); PG8_MMA(1, 1, At, B1); PG8_BAR; PG8_SCHED;
        }
        if constexpr (ALIGN_EPI) { if (wr == 0) PG8_BAR; }
        E(acc, cur, wr, wc, fr, fq);
        if (!has_next) break;
#pragma unroll
        for (int a = 0; a < 2; ++a)
#pragma unroll
            for (int b = 0; b < 2; ++b)
#pragma unroll
                for (int m = 0; m < 4; ++m)
#pragma unroll
                    for (int n = 0; n < 2; ++n) acc[a][b][m][n] = (f32x4){0.f, 0.f, 0.f, 0.f};
        cur = nxt; cA = nA; cB = nB; ++ui;
        if constexpr (ALIGN_EPI) { if (wr == 1) PG8_BAR; }
    }
    PG8_WAIT_V(0);
    if constexpr (!ALIGN_EPI) { if (wr == 0) PG8_BAR; }
    PG8_BAR;
#undef PG8_SA
#undef PG8_SB
#undef PG8_STAGE
#undef PG8_LDA
#undef PG8_LDB
#undef PG8_MMA
#undef PG8_WAIT_V
#undef PG8_WAIT_L
#undef PG8_BAR
#undef PG8_SCHED
}

__device__ __forceinline__ float sigmoidf_fast(float x) { return __builtin_amdgcn_rcpf(1.0f + __builtin_amdgcn_exp2f(-1.4426950408889634f * x)); }

template <bool MOD> struct EpiSwiGLU {
    static constexpr bool PERM = true;
    bf16_t* H; int ldh; const float* RS; const float* SHW;
    __device__ __forceinline__ void operator()(const f32x4 (&acc)[2][2][4][2], const Unit& u, int wr, int wc, int fr, int fq) const {
        const int row0 = u.pm * BM + wr * 64 + fr, c0 = wc * 32 + 8 * fq, col0 = u.pn * HALF + c0; const int mrow = u.pm >= NLAT / BM ? NB : (u.pm >> 4);
        f32x4 sg[2], su[2];
        if (MOD) {
#pragma unroll
            for (int n = 0; n < 2; ++n) { sg[n] = *(const f32x4*)(SHW + (size_t)mrow * (2 * DFF) + u.pn * BM + c0 + 4 * n); su[n] = *(const f32x4*)(SHW + (size_t)mrow * (2 * DFF) + u.pn * BM + HALF + c0 + 4 * n); } }
#pragma unroll
        for (int ai = 0; ai < 2; ++ai)
#pragma unroll
            for (int m = 0; m < 4; ++m) { const int row = row0 + ai * HALF + m * 16; bf16_t* rowp = H + (size_t)row * ldh + col0;
                float rinv = 1.f; if (MOD) { const f32x4 q = *(const f32x4*)(RS + (size_t)row * 4); rinv = 1.0f / sqrtf(((q[0] + q[1]) + (q[2] + q[3])) * (1.0f / DM) + EPS); }
                float h[8];
#pragma unroll
                for (int n = 0; n < 2; ++n)
#pragma unroll
                    for (int j = 0; j < 4; ++j) { float gt = acc[ai][0][m][n][j], up = acc[ai][1][m][n][j]; if (MOD) { gt = gt * rinv + sg[n][j]; up = up * rinv + su[n][j]; } h[4 * n + j] = gt * sigmoidf_fast(gt) * up; }
                u32x4 w; w.x = cvt_pk_bf16(h[0], h[1]); w.y = cvt_pk_bf16(h[2], h[3]); w.z = cvt_pk_bf16(h[4], h[5]); w.w = cvt_pk_bf16(h[6], h[7]);
                *(u32x4*)rowp = w; }
    }
};
template <bool MOD> struct EpiResid {
    static constexpr bool PERM = true;
    const float* base; float* out; const float* cbase; float* cout; const float* gate;
    const float* gvec; const float* scale; bf16_t* A2; float* RS; float coef;
    __device__ __forceinline__ void operator()(const f32x4 (&acc)[2][2][4][2], const Unit& u, int wr, int wc, int fr, int fq) const {
        const bool isc = u.pm >= NLAT / BM; const int mrow = isc ? NB : (u.pm >> 4);
        const float* bs = isc ? cbase - (size_t)NLAT * DM : base; float* os = isc ? cout - (size_t)NLAT * DM : out;
        const int row0 = u.pm * BM + wr * 64 + fr, col0 = u.pn * BM + wc * 32 + 8 * fq;
        PG8_LAS float* part = (PG8_LAS float*)(unsigned)(STAGE_BYTES + 1024);
        f32x4 gv[2][2], G[2][2];
#pragma unroll
        for (int bj = 0; bj < 2; ++bj)
#pragma unroll
            for (int n = 0; n < 2; ++n) { gv[bj][n] = *(const f32x4*)(gate + (size_t)mrow * NMODV + col0 + bj * HALF + n * 4) * coef;
                if (MOD) G[bj][n] = *(const f32x4*)(gvec + col0 + bj * HALF + n * 4) * (*(const f32x4*)(scale + (size_t)mrow * NMODV + col0 + bj * HALF + n * 4) + 1.0f); }
#pragma unroll
        for (int ai = 0; ai < 2; ++ai)
#pragma unroll
            for (int m = 0; m < 4; ++m) { const size_t off = (size_t)(row0 + ai * HALF + m * 16) * DM + col0; float ss = 0.f;
#pragma unroll
                for (int bj = 0; bj < 2; ++bj) {
                    const f32x4 x0 = *(const f32x4*)(bs + off + bj * HALF) + gv[bj][0] * acc[ai][bj][m][0], x1 = *(const f32x4*)(bs + off + bj * HALF + 4) + gv[bj][1] * acc[ai][bj][m][1];
                    *(f32x4*)(os + off + bj * HALF) = x0; *(f32x4*)(os + off + bj * HALF + 4) = x1;
                    if (MOD) { ss += (x0[0] * x0[0] + x0[1] * x0[1]) + (x0[2] * x0[2] + x0[3] * x0[3]) + (x1[0] * x1[0] + x1[1] * x1[1]) + (x1[2] * x1[2] + x1[3] * x1[3]);
                        const f32x4 a0 = x0 * G[bj][0], a1 = x1 * G[bj][1];
                        u32x4 w; w.x = cvt_pk_bf16(a0[0], a0[1]); w.y = cvt_pk_bf16(a0[2], a0[3]); w.z = cvt_pk_bf16(a1[0], a1[1]); w.w = cvt_pk_bf16(a1[2], a1[3]);
                        *(u32x4*)(A2 + off + bj * HALF) = w; } }
                if (MOD) { ss += __shfl_xor(ss, 16); ss += __shfl_xor(ss, 32); if (fq == 0) part[wc * BM + ai * HALF + wr * 64 + m * 16 + fr] = ss; }
                if (m & 1) asm volatile("" ::: "memory"); }
        if (MOD) {
            asm volatile("s_waitcnt lgkmcnt(0)\n\ts_barrier" ::: "memory");
            const int tid = (wr * 4 + wc) * 64 + fq * 16 + fr;
            if (tid < BM) RS[(size_t)(u.pm * BM + tid) * 4 + u.pn] = (part[tid] + part[BM + tid]) + (part[2 * BM + tid] + part[3 * BM + tid]);
        }
    }
};
template <bool MOD> struct EpiF32 {
    static constexpr bool PERM = false;
    float* C; int ldc; int tile_cols; const float* RS; const float* SHW;
    __device__ __forceinline__ void operator()(const f32x4 (&acc)[2][2][4][2], const Unit& u, int wr, int wc, int fr, int fq) const {
        const int row0 = u.pm * BM + wr * 64 + fr, col0 = (tile_cols ? 0 : u.pn * BM) + wc * 32 + 4 * fq; const int mrow = u.pm >= NLAT / BM ? NB : (u.pm >> 4);
        f32x4 sh[2][2];
        if (MOD) {
#pragma unroll
            for (int bj = 0; bj < 2; ++bj)
#pragma unroll
                for (int n = 0; n < 2; ++n) sh[bj][n] = *(const f32x4*)(SHW + (size_t)mrow * ldc + col0 + bj * HALF + n * 16); }
#pragma unroll
        for (int ai = 0; ai < 2; ++ai)
#pragma unroll
            for (int m = 0; m < 4; ++m) { const int row = row0 + ai * HALF + m * 16; float* rowp = C + (size_t)row * ldc + col0;
                float rinv = 1.f; if (MOD) { const f32x4 q = *(const f32x4*)(RS + (size_t)row * 4); rinv = 1.0f / sqrtf(((q[0] + q[1]) + (q[2] + q[3])) * (1.0f / DM) + EPS); }
#pragma unroll
                for (int bj = 0; bj < 2; ++bj)
#pragma unroll
                    for (int n = 0; n < 2; ++n) { f32x4 v = acc[ai][bj][m][n]; if (MOD) v = v * rinv + sh[bj][n]; *(f32x4*)(rowp + bj * HALF + n * 16) = v; } }
    }
};
struct EpiQ {
    static constexpr bool PERM = true;
    bf16_t* Q; const float* rope;
    __device__ __forceinline__ void operator()(const f32x4 (&acc)[2][2][4][2], const Unit& u, int wr, int wc, int fr, int fq) const {
        const int row0 = u.pm * BM + wr * 64 + fr, b = row0 >> 12, t0 = row0 & (SEQ - 1);
#pragma unroll
        for (int bj = 0; bj < 2; ++bj) { const int col8 = u.pn * BM + bj * HALF + wc * 32 + 8 * fq; if (col8 >= NH * DQK) continue;
            const int h = col8 / DQK, d = col8 - h * DQK; const bool rp = d >= 64;
            const unsigned qoff = (unsigned)((((b * NH + h) * SEQ + t0) * DQK + d) * 2);
            const unsigned roff = (unsigned)((t0 * 16 + (rp ? ((d - 64) >> 1) : 0)) * 8);
#pragma unroll
            for (int ai = 0; ai < 2; ++ai)
#pragma unroll
                for (int m = 0; m < 4; ++m) { const unsigned dr = (unsigned)(ai * HALF + m * 16);
                    float v[8];
#pragma unroll
                    for (int n = 0; n < 2; ++n)
#pragma unroll
                        for (int j = 0; j < 4; ++j) v[4 * n + j] = acc[ai][bj][m][n][j] * QSCALE;
                    if (rp) { const float* cs = (const float*)((const char*)rope + (roff + dr * 128u)); const f32x4 c0 = *(const f32x4*)cs, c1 = *(const f32x4*)(cs + 4);
                        const float cc[4] = {c0[0], c0[2], c1[0], c1[2]}, ss[4] = {c0[1], c0[3], c1[1], c1[3]};
#pragma unroll
                        for (int i = 0; i < 4; ++i) { const float t1 = v[2 * i], t2 = v[2 * i + 1]; v[2 * i] = t1 * cc[i] - t2 * ss[i]; v[2 * i + 1] = t1 * ss[i] + t2 * cc[i]; } }
                    u32x4 w; w.x = cvt_pk_bf16(v[0], v[1]); w.y = cvt_pk_bf16(v[2], v[3]); w.z = cvt_pk_bf16(v[4], v[5]); w.w = cvt_pk_bf16(v[6], v[7]);
                    *(u32x4*)((char*)Q + (qoff + dr * (unsigned)(DQK * 2))) = w; asm volatile("" ::: "memory"); } }
    }
};
struct EpiKV {
    static constexpr bool PERM = true;
    bf16_t* Kf; bf16_t* Vf;
    __device__ __forceinline__ void operator()(const f32x4 (&acc)[2][2][4][2], const Unit& u, int wr, int wc, int fr, int fq) const {
        const int row0 = u.pm * BM + wr * 64 + fr; const bool isc = u.pm >= NLAT / BM; int b, key0;
        if (isc) { const int r = row0 - NLAT; b = r >> 8; key0 = r & (CTXL - 1); } else { b = row0 >> 12; key0 = CTXL + (row0 & (SEQ - 1)); }
        const bool isk = wc < 2; const int d = (wc & 1) * 32 + 8 * fq;
        char* basep = isk ? (char*)Kf : (char*)Vf; const unsigned rs = isk ? (unsigned)(DQK * 2) : (unsigned)(DV * 2);
#pragma unroll
        for (int bj = 0; bj < 2; ++bj) { const int h = u.pn * 2 + bj;
            const unsigned off = (unsigned)((b * NH + h) * SKV + key0) * rs + (unsigned)(d * 2);
#pragma unroll
            for (int ai = 0; ai < 2; ++ai)
#pragma unroll
                for (int m = 0; m < 4; ++m) { const unsigned dr = (unsigned)(ai * HALF + m * 16);
                    const f32x4 v0 = acc[ai][bj][m][0], v1 = acc[ai][bj][m][1];
                    u32x4 w; w.x = cvt_pk_bf16(v0[0], v0[1]); w.y = cvt_pk_bf16(v0[2], v0[3]); w.z = cvt_pk_bf16(v1[0], v1[1]); w.w = cvt_pk_bf16(v1[2], v1[3]);
                    *(u32x4*)(basep + (off + dr * rs)) = w; asm volatile("" ::: "memory"); } }
    }
};
struct EpiY {
    static constexpr bool PERM = true;
    bf16_t* Zs;
    __device__ __forceinline__ void operator()(const f32x4 (&acc)[2][2][4][2], const Unit& u, int wr, int wc, int fr, int fq) const {
        const int g = u.pn >> 2, rl0 = (u.pm - 3 * g) * BM + wr * 64 + fr;
#pragma unroll
        for (int bj = 0; bj < 2; ++bj) { const int coll = (u.pn & 3) * BM + bj * HALF + wc * 32 + 8 * fq, t = coll >> 4, co8 = coll & 15;
#pragma unroll
            for (int ai = 0; ai < 2; ++ai)
#pragma unroll
                for (int m = 0; m < 4; ++m) { const int rl = rl0 + ai * HALF + m * 16, b = rl >> 6, k = rl & 63; const size_t tok = (size_t)b * SEQ + k * CH + t;
                    float z[8];
#pragma unroll
                    for (int n = 0; n < 2; ++n)
#pragma unroll
                        for (int j = 0; j < 4; ++j) { const float x = acc[ai][bj][m][n][j]; const float in = 1.5957691216057308f * (x + 0.044715f * x * x * x); z[4 * n + j] = x * sigmoidf_fast(in); }
                    u32x4 w; w.x = cvt_pk_bf16(z[0], z[1]); w.y = cvt_pk_bf16(z[2], z[3]); w.z = cvt_pk_bf16(z[4], z[5]); w.w = cvt_pk_bf16(z[6], z[7]);
                    *(u32x4*)(Zs + tok * 256 + g * 16 + co8) = w; } }
    }
};
struct EpiGLU {
    static constexpr bool PERM = true;
    bf16_t* O; int ldo; int coff;
    __device__ __forceinline__ void operator()(const f32x4 (&acc)[2][2][4][2], const Unit& u, int wr, int wc, int fr, int fq) const {
        const int row0 = u.pm * BM + wr * 64 + fr, col0 = coff + u.pn * HALF + wc * 32 + 8 * fq;
#pragma unroll
        for (int ai = 0; ai < 2; ++ai)
#pragma unroll
            for (int m = 0; m < 4; ++m) { bf16_t* rowp = O + (size_t)(row0 + ai * HALF + m * 16) * ldo + col0;
                float h[8];
#pragma unroll
                for (int n = 0; n < 2; ++n)
#pragma unroll
                    for (int j = 0; j < 4; ++j) h[4 * n + j] = acc[ai][0][m][n][j] * sigmoidf_fast(acc[ai][1][m][n][j]);
                u32x4 w; w.x = cvt_pk_bf16(h[0], h[1]); w.y = cvt_pk_bf16(h[2], h[3]); w.z = cvt_pk_bf16(h[4], h[5]); w.w = cvt_pk_bf16(h[6], h[7]);
                *(u32x4*)rowp = w; }
    }
};
}

namespace att {
using bf16x8 = __attribute__((ext_vector_type(8))) short;
using s16x4  = __attribute__((ext_vector_type(4))) short;
using f32x16 = __attribute__((ext_vector_type(16))) float;
using u32x4  = __attribute__((ext_vector_type(4))) unsigned;
constexpr int NW = 8, QBLK = 32, KVBLK = 64, NT = SKV / KVBLK;
constexpr int KROW = 208;
constexpr int SHM_K = KVBLK * KROW, SHM_V = KVBLK * DV * 2;
constexpr int OFF_V = 0, OFF_K = 2 * SHM_V, OFF_WS = OFF_K + 2 * SHM_K, OFF_OST = OFF_WS + NW * 64 * 4, LDS_BYTES = OFF_OST + NW * 4096;
constexpr float THRL = 8.0f;
#define SBAR() __builtin_amdgcn_sched_barrier(0)
__device__ __forceinline__ int crow(int r, int hi) { return (r & 3) + 8 * (r >> 2) + 4 * hi; }
__device__ __forceinline__ unsigned cvtpk(float lo, float hi) { unsigned r; asm volatile("v_cvt_pk_bf16_f32 %0, %1, %2" : "=v"(r) : "v"(lo), "v"(hi)); return r; }
template <bool FIRST> __device__ __forceinline__ void partialSM(f32x16& p0, f32x16& p1, float& m_reg, f32x16& negm, float& alpha) {
  float pmax = p0[0];
#pragma unroll
  for (int r = 1; r < 16; ++r) pmax = fmaxf(pmax, p0[r]);
#pragma unroll
  for (int r = 0; r < 16; ++r) pmax = fmaxf(pmax, p1[r]);
  { auto rr = __builtin_amdgcn_permlane32_swap(__float_as_uint(pmax), __float_as_uint(pmax), false, false);
    pmax = fmaxf(__uint_as_float(rr[0]), __uint_as_float(rr[1])); }
  if (!FIRST && __builtin_expect(__all(pmax <= THRL), 1)) { alpha = 1.f; }
  else { const float delta = FIRST ? pmax : fmaxf(pmax, 0.f); alpha = FIRST ? 0.f : __builtin_amdgcn_exp2f(-delta); m_reg += delta;
#pragma unroll
    for (int r = 0; r < 16; ++r) { p0[r] -= delta; p1[r] -= delta; }
    const float nm = -m_reg;
#pragma unroll
    for (int r = 0; r < 16; ++r) negm[r] = nm; }
#pragma unroll
  for (int r = 0; r < 16; ++r) p0[r] = __builtin_amdgcn_exp2f(p0[r]);
}
__device__ __forceinline__ void finishSM(f32x16& p0, f32x16& p1, float alpha, float& l_reg, bf16x8& pa0, bf16x8& pa1, bf16x8& pa2, bf16x8& pa3) {
#pragma unroll
  for (int r = 0; r < 16; ++r) p1[r] = __builtin_amdgcn_exp2f(p1[r]);
  float ps = 0;
#pragma unroll
  for (int r = 0; r < 16; ++r) ps += p0[r];
#pragma unroll
  for (int r = 0; r < 16; ++r) ps += p1[r];
  { auto rr = __builtin_amdgcn_permlane32_swap(__float_as_uint(ps), __float_as_uint(ps), false, false);
    ps = __uint_as_float(rr[0]) + __uint_as_float(rr[1]); }
  l_reg = l_reg * alpha + ps;
#define PK4(P, BASE, OUT) do { unsigned a0 = cvtpk(P[BASE + 0], P[BASE + 1]), a1 = cvtpk(P[BASE + 2], P[BASE + 3]);   \
    unsigned b0 = cvtpk(P[BASE + 4], P[BASE + 5]), b1 = cvtpk(P[BASE + 6], P[BASE + 7]);                              \
    auto r0 = __builtin_amdgcn_permlane32_swap(a0, b0, false, false); auto r1 = __builtin_amdgcn_permlane32_swap(a1, b1, false, false); \
    u32x4 w = {r0[0], r1[0], r0[1], r1[1]}; OUT = *reinterpret_cast<bf16x8*>(&w); } while (0)
  PK4(p0, 0, pa0); PK4(p0, 8, pa1); PK4(p1, 0, pa2); PK4(p1, 8, pa3);
#undef PK4
}
__device__ __forceinline__ void qkt(f32x16& p0, f32x16& p1, const char* Ks, const bf16x8* qr, const f32x16& negm, int r32, int hi) {
#pragma unroll
  for (int d0 = 0; d0 < 6; ++d0) { const int cb = (d0 * 16 + hi * 8) * 2;
    const bf16x8 b0 = *reinterpret_cast<const bf16x8*>(Ks + r32 * KROW + cb);
    const bf16x8 b1 = *reinterpret_cast<const bf16x8*>(Ks + (32 + r32) * KROW + cb);
    if (d0 == 0) { p0 = __builtin_amdgcn_mfma_f32_32x32x16_bf16(b0, qr[0], negm, 0, 0, 0); p1 = __builtin_amdgcn_mfma_f32_32x32x16_bf16(b1, qr[0], negm, 0, 0, 0); }
    else { p0 = __builtin_amdgcn_mfma_f32_32x32x16_bf16(b0, qr[d0], p0, 0, 0, 0); p1 = __builtin_amdgcn_mfma_f32_32x32x16_bf16(b1, qr[d0], p1, 0, 0, 0); } }
}
__device__ __forceinline__ int v_st(int k, int c) { const int kk = (k & ~0xC) | ((k & 4) << 1) | ((k & 8) >> 1); return ((kk >> 3) * 2 + (c >> 5)) * 512 + ((kk & 7) * 32 + (c & 31)) * 2; }
__device__ __forceinline__ int v_rd_base(int lane) { return ((lane & 3) << 3) | (((lane >> 2) & 3) << 6) | (((lane >> 4) & 1) << 5) | (((lane >> 5) & 1) << 8); }
constexpr int v_rd_off(int d0, int ks, int half) { return d0 * 512 + ks * 2048 + half * 1024; }
template <int OFF> __device__ __forceinline__ s16x4 tr_read(int vb) { s16x4 r; asm volatile("ds_read_b64_tr_b16 %0, %1 offset:%2" : "=&v"(r) : "v"(vb), "i"(OFF) : "memory"); return r; }
template <int D0> __device__ __forceinline__ void pv_one(f32x16& od, int vb, bf16x8 pa0, bf16x8 pa1, bf16x8 pa2, bf16x8 pa3) {
  const s16x4 l0 = tr_read<v_rd_off(D0, 0, 0)>(vb), h0 = tr_read<v_rd_off(D0, 0, 1)>(vb), l1 = tr_read<v_rd_off(D0, 1, 0)>(vb), h1 = tr_read<v_rd_off(D0, 1, 1)>(vb);
  const s16x4 l2 = tr_read<v_rd_off(D0, 2, 0)>(vb), h2 = tr_read<v_rd_off(D0, 2, 1)>(vb), l3 = tr_read<v_rd_off(D0, 3, 0)>(vb), h3 = tr_read<v_rd_off(D0, 3, 1)>(vb);
  asm volatile("s_waitcnt lgkmcnt(0)" ::: "memory"); SBAR();
#define PK(L, H) (bf16x8){L[0], L[1], L[2], L[3], H[0], H[1], H[2], H[3]}
  od = __builtin_amdgcn_mfma_f32_32x32x16_bf16(pa0, PK(l0, h0), od, 0, 0, 0);
  od = __builtin_amdgcn_mfma_f32_32x32x16_bf16(pa1, PK(l1, h1), od, 0, 0, 0);
  od = __builtin_amdgcn_mfma_f32_32x32x16_bf16(pa2, PK(l2, h2), od, 0, 0, 0);
  od = __builtin_amdgcn_mfma_f32_32x32x16_bf16(pa3, PK(l3, h3), od, 0, 0, 0);
#undef PK
}
__device__ __forceinline__ void pv_d0(f32x16* o, int vb, bf16x8 pa0, bf16x8 pa1, bf16x8 pa2, bf16x8 pa3) {
  pv_one<0>(o[0], vb, pa0, pa1, pa2, pa3); pv_one<1>(o[1], vb, pa0, pa1, pa2, pa3);
}
__device__ __forceinline__ void attn_unit(const unsigned short* __restrict__ Qb, const unsigned short* __restrict__ Kh, const unsigned short* __restrict__ Vh, unsigned short* __restrict__ Ob, int ldo, char* lds) {
  const int tid = tid_fresh(), wid = tid >> 6, lane = tid & 63, r32 = lane & 31, hi = lane >> 5;
  char* V_lds = lds + OFF_V; char* K_lds = lds + OFF_K;
  float* ws = (float*)(lds + OFF_WS) + wid * 64; float* li_l = ws; float* al_l = ws + 32;
  float m_reg = 0.f, l_reg = 0; f32x16 o[2] = {}; bf16x8 qr[6]; f32x16 negm = {}; asm volatile("" : "+v"(negm));
  const unsigned short* Qw = Qb + (size_t)(wid * QBLK + r32) * DQK + hi * 8;
#pragma unroll
  for (int d0 = 0; d0 < 6; ++d0) qr[d0] = *reinterpret_cast<const bf16x8*>(Qw + d0 * 16);
  const bool k2 = wid < 4; const int c2 = k2 ? 512 + tid : tid;
  const int kst0 = (tid / 12) * KROW + (tid % 12) * 16, kst1 = (c2 / 12) * KROW + (c2 % 12) * 16, vst = v_st(tid >> 3, (tid & 7) * 8);
  const int vb0 = (int)(uintptr_t)V_lds + v_rd_base(lane);
  struct { bf16x8 k0, k1, v; } sr_[2];
#define SLOAD(i, key0) do { sr_[i].k0 = *reinterpret_cast<const bf16x8*>(Kh + (size_t)(key0) * DQK + tid * 8); sr_[i].k1 = *reinterpret_cast<const bf16x8*>(Kh + (size_t)(key0) * DQK + c2 * 8); \
    sr_[i].v = *reinterpret_cast<const bf16x8*>(Vh + (size_t)(key0) * DV + tid * 8); } while (0)
#define SWRITE(b, i) do { *(bf16x8*)(K_lds + (b) * SHM_K + kst0) = sr_[i].k0; if (k2) *(bf16x8*)(K_lds + (b) * SHM_K + kst1) = sr_[i].k1; *(bf16x8*)(V_lds + (b) * SHM_V + vst) = sr_[i].v; } while (0)
#define SWAIT() asm volatile("s_waitcnt vmcnt(3)" ::: "memory")
#define RESC(a) do { if (__any((a) < 1.f)) { if (hi == 0) al_l[r32] = (a); asm volatile("s_waitcnt lgkmcnt(0)" ::: "memory"); \
    _Pragma("unroll") for (int d = 0; d < 2; ++d) _Pragma("unroll") for (int r = 0; r < 16; ++r) o[d][r] *= al_l[crow(r, hi)]; } } while (0)
  f32x16 pA0, pA1, pB0, pB1; float alA, alB; bf16x8 pa0, pa1, pa2, pa3;
  SLOAD(0, 0); asm volatile("s_waitcnt vmcnt(0)" ::: "memory"); SWRITE(0, 0); __syncthreads();
  qkt(pA0, pA1, K_lds, qr, negm, r32, hi); partialSM<true>(pA0, pA1, m_reg, negm, alA);
  SLOAD(1, KVBLK); SLOAD(0, 2 * KVBLK);
  SWAIT(); SWRITE(1, 1); __syncthreads();
  for (int j = 1; j + 1 < NT; j += 2) {
    SBAR(); qkt(pB0, pB1, K_lds + SHM_K, qr, negm, r32, hi);
    finishSM(pA0, pA1, alA, l_reg, pa0, pa1, pa2, pa3); SBAR();
    SLOAD(1, (j + 2) * KVBLK); SBAR();
    pv_d0(o, vb0, pa0, pa1, pa2, pa3); partialSM<false>(pB0, pB1, m_reg, negm, alB);
    __syncthreads(); SWAIT(); SWRITE(0, 0);
    RESC(alB); __syncthreads();
    SBAR(); qkt(pA0, pA1, K_lds, qr, negm, r32, hi);
    finishSM(pB0, pB1, alB, l_reg, pa0, pa1, pa2, pa3); SBAR();
    if (j + 3 < NT) SLOAD(0, (j + 3) * KVBLK); SBAR();
    pv_d0(o, vb0 + SHM_V, pa0, pa1, pa2, pa3); partialSM<false>(pA0, pA1, m_reg, negm, alA);
    __syncthreads(); SWAIT(); SWRITE(1, 1);
    RESC(alA); __syncthreads();
  }
  SBAR(); qkt(pB0, pB1, K_lds + SHM_K, qr, negm, r32, hi);
  finishSM(pA0, pA1, alA, l_reg, pa0, pa1, pa2, pa3); SBAR();
  pv_d0(o, vb0, pa0, pa1, pa2, pa3); partialSM<false>(pB0, pB1, m_reg, negm, alB);
  __syncthreads(); RESC(alB);
  finishSM(pB0, pB1, alB, l_reg, pa0, pa1, pa2, pa3); SBAR();
  pv_d0(o, vb0 + SHM_V, pa0, pa1, pa2, pa3);
  if (hi == 0) li_l[r32] = l_reg; asm volatile("s_waitcnt lgkmcnt(0)" ::: "memory");
  float rli[16];
#pragma unroll
  for (int r = 0; r < 16; ++r) rli[r] = __builtin_amdgcn_rcpf(li_l[crow(r, hi)]);
  { unsigned short* stg = (unsigned short*)(lds + OFF_OST) + wid * 2048;
#pragma unroll
    for (int r = 0; r < 16; ++r) { const int orow = crow(r, hi);
#pragma unroll
      for (int d0 = 0; d0 < 2; ++d0) { const unsigned pk = cvtpk(o[d0][r] * rli[r], 0.f); stg[orow * 64 + d0 * 32 + r32] = (unsigned short)pk; } }
    asm volatile("s_waitcnt lgkmcnt(0)" ::: "memory");
    unsigned short* Ow = Ob + (size_t)(wid * QBLK) * ldo;
#pragma unroll
    for (int i = 0; i < 4; ++i) { const int row = i * 8 + (lane >> 3), ch = lane & 7; const u32x4 v = *(const u32x4*)(stg + row * 64 + ch * 8); *(u32x4*)(Ow + (size_t)row * ldo + ch * 8) = v; } }
  __syncthreads();
#undef SLOAD
#undef SWRITE
#undef SWAIT
#undef RESC
}
#undef SBAR
}

constexpr size_t al256(size_t x) { return (x + 255) / 256 * 256; }
constexpr size_t WS_CTL = 0, CTL_BYTES = 1u << 20;
constexpr size_t WS_MODS = WS_CTL + CTL_BYTES;
constexpr size_t WS_ROPE = WS_MODS + al256((size_t)9 * NMODV * 4);
constexpr size_t WS_KTAB = WS_ROPE + al256((size_t)SEQ * 16 * 2 * 4);
constexpr size_t WS_RS   = WS_KTAB + al256((size_t)SG * 2 * CH * 256 * 4);
constexpr size_t WS_SHWI = WS_RS + al256((size_t)MT * 4 * 4);
constexpr size_t WS_SHWG = WS_SHWI + al256((size_t)9 * DINP * 4);
constexpr size_t WS_WGU1 = WS_SHWG + al256((size_t)9 * 2 * DFF * 4);
constexpr size_t WS_WD1  = WS_WGU1 + al256((size_t)2 * DFF * DM * 2);
constexpr size_t WS_WGU2 = WS_WD1 + al256((size_t)DM * DFF * 2);
constexpr size_t WS_WD2  = WS_WGU2 + al256((size_t)2 * DFF * DM * 2);
constexpr size_t WS_WIN  = WS_WD2 + al256((size_t)DM * DFF * 2);
constexpr size_t WS_WUQ  = WS_WIN + al256((size_t)DINP * DM * 2);
constexpr size_t WS_WUKV = WS_WUQ + al256((size_t)1280 * 256 * 2);
constexpr size_t WS_WOUT = WS_WUKV + al256((size_t)1536 * 256 * 2);
constexpr size_t WS_WGLU = WS_WOUT + al256((size_t)DM * DM * 2);
constexpr size_t WS_BTY  = WS_WGLU + al256((size_t)512 * 256 * 2);
constexpr size_t WS_BTE  = WS_BTY + al256((size_t)SG * 1024 * AUK * 2);
constexpr size_t WS_AU   = WS_BTE + al256((size_t)SG * 256 * 1024 * 2);
constexpr size_t WS_E    = WS_AU + al256((size_t)SG * AUR * AUK * 2);
constexpr size_t WS_A    = WS_E + al256((size_t)SG * AUR * 256 * 4);
constexpr size_t WS_X1C  = WS_A + al256((size_t)MT * DM * 2);
constexpr size_t WS_CQ   = WS_X1C + al256((size_t)NCTX * DM * 4);
constexpr size_t WS_CKV  = WS_CQ + al256((size_t)NLAT * 256 * 2);
constexpr size_t WS_V    = WS_CKV + al256((size_t)MT * 256 * 2);
constexpr size_t WS_ZS   = WS_V + al256((size_t)NB * NH * SKV * DV * 2);
constexpr size_t WS_H    = WS_ZS + al256((size_t)NLAT * 256 * 2);
constexpr size_t WS_P    = WS_H;
constexpr size_t WS_Q    = WS_H;
constexpr size_t WS_K    = WS_P + al256((size_t)MT * DINP * 4);
constexpr size_t WS_END  = WS_H + al256((size_t)MT * DFF * 2);
static_assert(WS_K + (size_t)NB * NH * SKV * DQK * 2 <= WS_END && WS_P + (size_t)MT * DINP * 4 <= WS_END, "overlays fit in H");
constexpr size_t WS_A4 = WS_CQ;
static_assert(WS_A4 + (size_t)NLAT * DM * 2 <= WS_H, "A4 overlay fits before H");
static_assert(WS_END <= (size_t)512 * 1024 * 1024, "workspace map must fit 512 MiB");

#define LAS __attribute__((address_space(3)))
typedef unsigned short bf16;
typedef unsigned v4u __attribute__((ext_vector_type(4)));
typedef unsigned v2u __attribute__((ext_vector_type(2)));
typedef float f32x4 __attribute__((ext_vector_type(4)));
typedef float f32x2 __attribute__((ext_vector_type(2)));
#define LDS_WAIT() asm volatile("s_waitcnt lgkmcnt(0)" ::: "memory")
__device__ __forceinline__ unsigned f2bf(float f) { unsigned u = __builtin_bit_cast(unsigned, f); return (u + 0x7fffu + ((u >> 16) & 1u)) >> 16; }
__device__ __forceinline__ unsigned pk2(float lo, float hi) { return f2bf(lo) | (f2bf(hi) << 16); }
__device__ __forceinline__ float bf2f(unsigned short b) { return __builtin_bit_cast(float, (unsigned)b << 16); }
__device__ __forceinline__ float wave_sum(float v) {
#pragma unroll
    for (int o = 1; o < 64; o <<= 1) v += __shfl_xor(v, o);
    return v;
}

#define XB_TMO      128
#define XB_XCNT(j)  (256  + 64 * (j))
#define XB_XSUB(j)  (1280 + 64 * (j))
#define XB_XGEN(j)  (2304 + 64 * (j))
#define XB_TOP      3328
#define XB_TOPGEN   3392
#define XCD_BAR_WORDS 3456
#define XB_SPIN_CAP (1u << 22)
__device__ __forceinline__ unsigned xb_ld(unsigned* p)              { return __hip_atomic_load(p, __ATOMIC_RELAXED, __HIP_MEMORY_SCOPE_AGENT); }
__device__ __forceinline__ unsigned xb_add(unsigned* p, unsigned v) { return __hip_atomic_fetch_add(p, v, __ATOMIC_RELAXED, __HIP_MEMORY_SCOPE_AGENT); }
__device__ __forceinline__ unsigned xb_xcc_id() { return (unsigned)__builtin_amdgcn_s_getreg((3 << 11) | 20) & 0xFu; }
#define XB_SPIN(cond, bar) do { unsigned _sp = 0; while (cond) { __builtin_amdgcn_s_sleep(1); \
    if ((++_sp & 255u) == 0u) { if (xb_ld(&(bar)[XB_TMO])) break; if (_sp > XB_SPIN_CAP) { atomicAdd(&(bar)[XB_TMO], 1u); break; } } } } while (0)
struct XcdBarrier { unsigned* bar; unsigned x; volatile LAS unsigned* st; };
__device__ __forceinline__ XcdBarrier xcd_barrier_post(unsigned* bar, volatile LAS unsigned* st) {
    XcdBarrier b; b.bar = bar; b.x = xb_xcc_id(); b.st = st;
    if (threadIdx.x == 0) (void)xb_add(&bar[XB_XCNT(b.x)], 1u);
    return b;
}
__device__ __forceinline__ void xcd_barrier_complete(unsigned* bar, unsigned x, unsigned& nloc, unsigned& nx) {
    const unsigned G = gridDim.x * gridDim.y * gridDim.z;
    unsigned sum, cnt, mine, sp = 0u;
    for (;;) {
        sum = 0u; cnt = 0u; mine = 0u;
#pragma unroll
        for (unsigned j = 0; j < 16; ++j) { const unsigned c = xb_ld(&bar[XB_XCNT(j)]); sum += c; cnt += (c > 0u) ? 1u : 0u; mine = (j == x) ? c : mine; }
        if (sum == G) break;
        __builtin_amdgcn_s_sleep(1);
        if ((++sp & 255u) == 0u) { if (xb_ld(&bar[XB_TMO])) break; if (sp > XB_SPIN_CAP) { atomicAdd(&bar[XB_TMO], 1u); break; } }
    }
    nloc = mine > 0u ? mine : 1u; nx = cnt > 0u ? cnt : 1u;
}
__device__ __forceinline__ void xcd_barrier(const XcdBarrier& b) {
    asm volatile("s_waitcnt vmcnt(0)" ::: "memory");
    __syncthreads();
    if (threadIdx.x == 0) {
        unsigned* bar = b.bar;
        __builtin_amdgcn_s_waitcnt(0);
        unsigned nloc = b.st[0], nx = b.st[1];
        if (nloc == 0u) { xcd_barrier_complete(bar, b.x, nloc, nx); b.st[0] = nloc; b.st[1] = nx; }
        const unsigned old = xb_add(&bar[XB_XSUB(b.x)], 1u);
        const unsigned gen = old / nloc;
        if (old + 1u == (gen + 1u) * nloc) {
            __builtin_amdgcn_fence(__ATOMIC_RELEASE, "agent");
            asm volatile("s_waitcnt vmcnt(0)" ::: "memory");
            const unsigned og = xb_add(&bar[XB_TOP], 1u);
            const unsigned tg = og / nx;
            if (og + 1u == (tg + 1u) * nx) xb_add(&bar[XB_TOPGEN], 1u);
            else XB_SPIN(xb_ld(&bar[XB_TOPGEN]) == tg, bar);
            __builtin_amdgcn_fence(__ATOMIC_ACQUIRE, "agent");
            xb_add(&bar[XB_XGEN(b.x)], 1u);
            asm volatile("s_waitcnt vmcnt(0)" ::: "memory");
        } else {
            XB_SPIN(xb_ld(&bar[XB_XGEN(b.x)]) == gen, bar);
            __builtin_amdgcn_fence(__ATOMIC_ACQUIRE, "agent");
            asm volatile("s_waitcnt vmcnt(0)" ::: "memory");
        }
    }
    __syncthreads();
}

constexpr int NWAVES = 8, NTHREADS = 512, NPHASES = 17;
constexpr int RING_BYTES = 131072, LDSCTL_OFF = RING_BYTES, LDS_BYTES = 147456;
struct Args { const float* in[31]; float* out; unsigned char* ws; int ph_lo, ph_hi, use_bar, pad; };
enum { I_X = 0, I_C, I_CTX, I_CCTX, I_WMOD, I_BMOD, I_GFFN1, I_WGU1, I_WD1, I_GMIX, I_WIN, I_GCQ, I_WUQ, I_GCKV, I_WUKV, I_LAMRE, I_LAMIM, I_LOGDT, I_BRE, I_BIM, I_CRE, I_CIM,
       I_DSKIP, I_WGLU, I_GMLA, I_GSSM, I_WOUT, I_GFFN2, I_WGU2, I_WD2, I_GFINAL };

struct S5P { float lrdt, lidt_rev_hi; double lidt_rev; float fr, fi; };
__device__ __forceinline__ void s5_par(const float* lam_re, const float* lam_im, const float* log_dt, int d, int g, int p, float& lrdt, double& rev, float& fr, float& fi) {
    const float dt = __expf(log_dt[d * SG + g]); const float lr = fminf(lam_re[(d * SG + g) * SP + p], -1e-4f), li = lam_im[(d * SG + g) * SP + p];
    lrdt = lr * dt; rev = (double)li * (double)dt * 0.15915494309189535;
    double r1 = rev - __builtin_rint(rev); const float rf = (float)r1;
    const float mag = __expf(lrdt), ar = mag * __builtin_amdgcn_cosf(rf), ai = mag * __builtin_amdgcn_sinf(rf);
    const float den = lr * lr + li * li;
    fr = ((ar - 1.0f) * lr + ai * li) / den; fi = (ai * lr - (ar - 1.0f) * li) / den;
}
__device__ __forceinline__ void s5_apow(float lrdt, double rev, int e, float& wr, float& wi) {
    const float mag = __expf(lrdt * (float)e); double r = rev * (double)e; r -= __builtin_rint(r); const float rf = (float)r;
    wr = mag * __builtin_amdgcn_cosf(rf); wi = mag * __builtin_amdgcn_sinf(rf);
}

__device__ __forceinline__ void tr_item(const float* W, int N, int k0, int n0, bf16* WT, int ldt, int drow0, LAS float* scr, int lane) {
#pragma unroll 8
    for (int i = 0; i < 32; ++i) { const int kk = 2 * i + (lane >> 5); scr[kk * 33 + (lane & 31)] = W[(size_t)(k0 + kk) * N + n0 + (lane & 31)]; }
    LDS_WAIT(); asm volatile("" ::: "memory");
    const int c = lane & 7;
#pragma unroll
    for (int j = 0; j < 4; ++j) { const int n = (lane >> 3) + 8 * j; const LAS float* s = scr + (8 * c) * 33 + n;
        v4u o; o.x = pk2(s[0 * 33], s[1 * 33]); o.y = pk2(s[2 * 33], s[3 * 33]); o.z = pk2(s[4 * 33], s[5 * 33]); o.w = pk2(s[6 * 33], s[7 * 33]);
        *(v4u*)(WT + (size_t)(drow0 + n) * ldt + k0 + 8 * c) = o; }
    LDS_WAIT(); asm volatile("" ::: "memory");
}
__device__ __forceinline__ int glu_row(int n0, int Nh) { const int hh = n0 >= Nh ? 1 : 0, j = n0 - hh * Nh; return (j >> 7) * 256 + hh * 128 + (j & 127); }

typedef const __attribute__((address_space(4))) Args* ArgsP;
__device__ __forceinline__ ArgsP get_args() { ArgsP p = (ArgsP)__builtin_amdgcn_kernarg_segment_ptr(); asm volatile("" : "+s"(p)); return p; }

__device__ __forceinline__ void deferred_prologue(unsigned char* lds_raw, int db, int NDB) {
    ArgsP ap = get_args();
    LAS unsigned char* lds = (LAS unsigned char*)lds_raw;
    const int tid = tid_fresh(), lane = tid & 63, wave = __builtin_amdgcn_readfirstlane(tid >> 6);
    const int gw = db * NWAVES + wave, NGW = NDB * NWAVES, G = NDB, bx = db, vcu = db;
    unsigned char* ws = ap->ws;
    float* MODS = (float*)(ws + WS_MODS); float* ROPE = (float*)(ws + WS_ROPE); float* KTAB = (float*)(ws + WS_KTAB);
    bf16* WGU2 = (bf16*)(ws + WS_WGU2); bf16* WD2 = (bf16*)(ws + WS_WD2);
    bf16* WIN = (bf16*)(ws + WS_WIN); bf16* WUQ = (bf16*)(ws + WS_WUQ); bf16* WUKV = (bf16*)(ws + WS_WUKV); bf16* WOUT = (bf16*)(ws + WS_WOUT); bf16* WGLU = (bf16*)(ws + WS_WGLU);
    bf16* BTY = (bf16*)(ws + WS_BTY); bf16* BTE = (bf16*)(ws + WS_BTE);
    float* SHWI = (float*)(ws + WS_SHWI); float* SHWG = (float*)(ws + WS_SHWG);
    LAS float* fl = (LAS float*)lds;
    __syncthreads();
            {
                LAS float* Cr = fl; LAS float* Ci = fl + 1024; LAS float* Br = fl + 2048; LAS float* Bi = fl + 3072; LAS float* Wr = fl + 4096; LAS float* Wi = fl + 4160;
                for (int item = bx; item < 2 * SG * 8; item += G) {
                    const int d = item >> 7, g = (item >> 3) & 15, oct = item & 7;
                    __syncthreads();
                    for (int i = tid; i < 1024; i += NTHREADS) {
                        Cr[i] = ap->in[I_CRE][(size_t)(d * SG + g) * 1024 + i]; Ci[i] = ap->in[I_CIM][(size_t)(d * SG + g) * 1024 + i];
                        const int p = i >> 4; float lrdt, fr, fi; double rev; s5_par(ap->in[I_LAMRE], ap->in[I_LAMIM], ap->in[I_LOGDT], d, g, p, lrdt, rev, fr, fi);
                        const float br = ap->in[I_BRE][(size_t)(d * SG + g) * 1024 + i], bi = ap->in[I_BIM][(size_t)(d * SG + g) * 1024 + i];
                        Br[i] = fr * br - fi * bi; Bi[i] = fr * bi + fi * br; }
                    for (int tt = 0; tt < 8; ++tt) { const int tau = oct * 8 + tt;
                        __syncthreads();
                        if (tid < SP) { float lrdt, fr, fi; double rev; s5_par(ap->in[I_LAMRE], ap->in[I_LAMIM], ap->in[I_LOGDT], d, g, tid, lrdt, rev, fr, fi); float wr, wi; s5_apow(lrdt, rev, tau, wr, wi); Wr[tid] = wr; Wi[tid] = wi; }
                        __syncthreads();
                        if (tid < 256) { const int co = tid >> 4, ci = tid & 15; float s = 0.f;
                            for (int p = 0; p < SP; ++p) { const float cr = Cr[co * 64 + p], cim = Ci[co * 64 + p], wr = Wr[p], wi = Wi[p];
                                const float cwr = cr * wr - cim * wi, cwi = cr * wi + cim * wr; s += cwr * Br[p * 16 + ci] - cwi * Bi[p * 16 + ci]; }
                            KTAB[((size_t)(g * 2 + d) * CH + tau) * 256 + tid] = s; }
                    }
                }
                __syncthreads();
            }
            LAS float* scr = (LAS float*)(lds + wave * 16384);
            {
                const int I1 = (DM / 64) * (2 * DFF / 32), I2 = (DFF / 64) * (DM / 32), I3 = (DM / 64) * (672 / 32), I4 = (256 / 64) * (1152 / 32), I5 = (128 / 64) * (1536 / 32), I6 = (DM / 64) * (DM / 32), I7 = (256 / 64) * (512 / 32);
                const int NIT = I1 + I2 + I4 + I5 + I6 + I7;
                for (int it = gw; it < NIT; it += NGW) {
                    int r = it;
                    if (r < I1) { const int nblk = 2 * DFF / 32, kb = r / nblk, nb = r % nblk; tr_item(ap->in[I_WGU2], 2 * DFF, kb * 64, nb * 32, WGU2, DM, glu_row(nb * 32, DFF), scr, lane); continue; } r -= I1;
                    if (r < I2) { const int nblk = DM / 32, kb = r / nblk, nb = r % nblk; tr_item(ap->in[I_WD2], DM, kb * 64, nb * 32, WD2, DFF, nb * 32, scr, lane); continue; } r -= I2;
                    if (r < I4) { const int nblk = 1152 / 32, kb = r / nblk, nb = r % nblk; tr_item(ap->in[I_WUQ], 1152, kb * 64, nb * 32, WUQ, 256, nb * 32, scr, lane); continue; } r -= I4;
                    if (r < I5) { const int nblk = 1536 / 32, kb = r / nblk, nb = r % nblk; tr_item(ap->in[I_WUKV], 1536, kb * 64, nb * 32, WUKV, 256, nb * 32, scr, lane); continue; } r -= I5;
                    if (r < I6) { const int nblk = DM / 32, kb = r / nblk, nb = r % nblk; tr_item(ap->in[I_WOUT], DM, kb * 64, nb * 32, WOUT, DM, nb * 32, scr, lane); continue; } r -= I6;
                    { const int nblk = 512 / 32, kb = r / nblk, nb = r % nblk; tr_item(ap->in[I_WGLU], 512, kb * 64, nb * 32, WGLU, 256, glu_row(nb * 32, 256), scr, lane); }
                }
            }
            { const v4u z = {0u, 0u, 0u, 0u}; const int gt = vcu * NTHREADS + tid, NGT = G * NTHREADS;
              for (int i = gt; i < 128 * 256 / 8; i += NGT) *(v4u*)(WUQ + (size_t)1152 * 256 + (size_t)i * 8) = z;
              for (int i = gt; i < 1536 * 16; i += NGT) *(v4u*)(WUKV + (size_t)(i >> 4) * 256 + 128 + (i & 15) * 8) = z;
              for (int i = gt; i < SEQ * 16; i += NGT) { const int t = i >> 4, ii = i & 15; const float pos = (float)(ii < 8 ? (t >> 6) : (t & 63));
                  const float invf = exp2f(-(float)(ii & 7) * (13.287712379549449f / 8.0f)); const float ang = pos * invf;
                  double rv = (double)ang * 0.15915494309189535; rv -= __builtin_rint(rv); const float rf = (float)rv;
                  *(f32x2*)(ROPE + (size_t)i * 2) = (f32x2){__builtin_amdgcn_cosf(rf), __builtin_amdgcn_sinf(rf)}; }
            }
            for (int it = gw; it < SG * 2 * CH; it += NGW) { const int g = it >> 7, d = (it >> 6) & 1, t = it & 63, p = lane;
                float lrdt, fr, fi; double rev; s5_par(ap->in[I_LAMRE], ap->in[I_LAMIM], ap->in[I_LOGDT], d, g, p, lrdt, rev, fr, fi);
                float wr, wi; s5_apow(lrdt, rev, d == 0 ? t + 1 : CH - t, wr, wi);
#pragma unroll 4
                for (int co = 0; co < SC; ++co) { const float cr = ap->in[I_CRE][((size_t)(d * SG + g) * SC + co) * SP + p], cim = ap->in[I_CIM][((size_t)(d * SG + g) * SC + co) * SP + p];
                    const float re = cr * wr - cim * wi, im = cr * wi + cim * wr;
                    *(unsigned*)(BTY + ((size_t)g * 1024 + t * 16 + co) * AUK + 1024 + d * 128 + 2 * p) = pk2(re, -im); } }
            for (int it = gw; it < SG * 2 * SP; it += NGW) { const int g = it >> 7, d = (it >> 6) & 1, p = it & 63, s = lane;
                float lrdt, fr, fi; double rev; s5_par(ap->in[I_LAMRE], ap->in[I_LAMIM], ap->in[I_LOGDT], d, g, p, lrdt, rev, fr, fi);
                float wr, wi; s5_apow(lrdt, rev, d == 0 ? CH - 1 - s : s, wr, wi);
                float ore[16], oim[16];
#pragma unroll
                for (int ci = 0; ci < SC; ++ci) { const float br = ap->in[I_BRE][((size_t)(d * SG + g) * SP + p) * SC + ci], bi = ap->in[I_BIM][((size_t)(d * SG + g) * SP + p) * SC + ci];
                    const float bbr = fr * br - fi * bi, bbi = fr * bi + fi * br; ore[ci] = wr * bbr - wi * bbi; oim[ci] = wr * bbi + wi * bbr; }
                bf16* r0 = BTE + ((size_t)g * 256 + d * 128 + 2 * p) * 1024 + s * 16; bf16* r1 = r0 + 1024;
                v4u a, b2; a.x = pk2(ore[0], ore[1]); a.y = pk2(ore[2], ore[3]); a.z = pk2(ore[4], ore[5]); a.w = pk2(ore[6], ore[7]); b2.x = pk2(ore[8], ore[9]); b2.y = pk2(ore[10], ore[11]); b2.z = pk2(ore[12], ore[13]); b2.w = pk2(ore[14], ore[15]);
                *(v4u*)r0 = a; *(v4u*)(r0 + 8) = b2;
                a.x = pk2(oim[0], oim[1]); a.y = pk2(oim[2], oim[3]); a.z = pk2(oim[4], oim[5]); a.w = pk2(oim[6], oim[7]); b2.x = pk2(oim[8], oim[9]); b2.y = pk2(oim[10], oim[11]); b2.z = pk2(oim[12], oim[13]); b2.w = pk2(oim[14], oim[15]);
                *(v4u*)r1 = a; *(v4u*)(r1 + 8) = b2; }
    asm volatile("s_waitcnt vmcnt(0)" ::: "memory");
}

template <int SHW_LO, int SHW_HI> __device__ __forceinline__ void shw_items(int gw, int NGW, int lane, const float* MODS, const bf16* WIN, const bf16* WGU2, float* SHWI, float* SHWG) {
                for (int it = gw + SHW_LO; it < SHW_HI; it += NGW) { const bool isw = it < DINP; const int n = isw ? it : it - DINP; const bf16* wrow = (isw ? WIN : WGU2) + (size_t)n * DM + 16 * lane;
                    const v4u w0 = *(const v4u*)wrow, w1 = *(const v4u*)(wrow + 8); const unsigned ww[8] = {w0.x, w0.y, w0.z, w0.w, w1.x, w1.y, w1.z, w1.w}; float wf[16];
#pragma unroll
                    for (int q = 0; q < 8; ++q) { wf[2 * q] = __builtin_bit_cast(float, ww[q] << 16); wf[2 * q + 1] = __builtin_bit_cast(float, ww[q] & 0xffff0000u); }
                    float res = 0.f;
                    for (int r = 0; r < 9; ++r) { const float* sh = MODS + (size_t)r * NMODV + (isw ? 3 : 6) * DM + 16 * lane; float d = 0.f;
#pragma unroll
                        for (int q = 0; q < 4; ++q) { const f32x4 x = *(const f32x4*)(sh + 4 * q); d += (x.x * wf[4 * q] + x.y * wf[4 * q + 1]) + (x.z * wf[4 * q + 2] + x.w * wf[4 * q + 3]); }
                        d = wave_sum(d); if (lane == r) res = d; }
                    if (lane < 9) (isw ? SHWI + (size_t)lane * DINP : SHWG + (size_t)lane * (2 * DFF))[n] = res; }
}
__device__ __forceinline__ void deferred_fill(int gw, int NGW) {
    ArgsP ap = get_args();
    const int lane = tid_fresh() & 63;
    unsigned char* ws = ap->ws;
    float* MODS = (float*)(ws + WS_MODS); float* KTAB = (float*)(ws + WS_KTAB); bf16* WGU2 = (bf16*)(ws + WS_WGU2); bf16* WIN = (bf16*)(ws + WS_WIN); bf16* BTY = (bf16*)(ws + WS_BTY);
    float* SHWI = (float*)(ws + WS_SHWI); float* SHWG = (float*)(ws + WS_SHWG);
                for (int it = gw; it < SG * CH * SC; it += NGW) { const int g = it >> 10, t = (it >> 4) & 63, co = it & 15, s = lane;
                    float v[16];
#pragma unroll
                    for (int ci = 0; ci < 16; ++ci) v[ci] = 0.f;
                    if (s <= t) { const float* k0 = KTAB + ((size_t)(g * 2 + 0) * CH + (t - s)) * 256 + co * 16;
#pragma unroll
                        for (int q = 0; q < 4; ++q) { const f32x4 x = *(const f32x4*)(k0 + 4 * q); v[4 * q] += x.x; v[4 * q + 1] += x.y; v[4 * q + 2] += x.z; v[4 * q + 3] += x.w; } }
                    if (s >= t) { const float* k1 = KTAB + ((size_t)(g * 2 + 1) * CH + (s - t)) * 256 + co * 16;
#pragma unroll
                        for (int q = 0; q < 4; ++q) { const f32x4 x = *(const f32x4*)(k1 + 4 * q); v[4 * q] += x.x; v[4 * q + 1] += x.y; v[4 * q + 2] += x.z; v[4 * q + 3] += x.w; } }
                    if (s == t) { const float dsk = ap->in[I_DSKIP][g * 16 + co];
#pragma unroll
                        for (int ci = 0; ci < 16; ++ci) v[ci] += (ci == co) ? dsk : 0.f; }
                    bf16* dst = BTY + ((size_t)g * 1024 + t * 16 + co) * AUK + s * 16;
                    v4u a, b2; a.x = pk2(v[0], v[1]); a.y = pk2(v[2], v[3]); a.z = pk2(v[4], v[5]); a.w = pk2(v[6], v[7]); b2.x = pk2(v[8], v[9]); b2.y = pk2(v[10], v[11]); b2.z = pk2(v[12], v[13]); b2.w = pk2(v[14], v[15]);
                    *(v4u*)dst = a; *(v4u*)(dst + 8) = b2; }
    shw_items<DINP, DINP + 2 * DFF>(gw, NGW, lane, MODS, WIN, WGU2, SHWI, SHWG);
}
template <int ph> __device__ __forceinline__ void run_phase(unsigned char* lds_raw) {
    ArgsP ap = get_args();
    LAS unsigned char* lds = (LAS unsigned char*)lds_raw;
    const int tid = tid_fresh(), lane = tid & 63, wave = __builtin_amdgcn_readfirstlane(tid >> 6);
    const int G = gridDim.x, bx = blockIdx.x, vcu = (G % 8 == 0) ? (bx % 8) * (G / 8) + bx / 8 : bx;
    const int gw = vcu * NWAVES + wave, NGW = G * NWAVES;
    unsigned char* ws = ap->ws;
    float* MODS = (float*)(ws + WS_MODS); float* ROPE = (float*)(ws + WS_ROPE); float* KTAB = (float*)(ws + WS_KTAB);
    bf16* WGU1 = (bf16*)(ws + WS_WGU1); bf16* WD1 = (bf16*)(ws + WS_WD1); bf16* WGU2 = (bf16*)(ws + WS_WGU2); bf16* WD2 = (bf16*)(ws + WS_WD2);
    bf16* WIN = (bf16*)(ws + WS_WIN); bf16* WUQ = (bf16*)(ws + WS_WUQ); bf16* WUKV = (bf16*)(ws + WS_WUKV); bf16* WOUT = (bf16*)(ws + WS_WOUT); bf16* WGLU = (bf16*)(ws + WS_WGLU);
    bf16* BTY = (bf16*)(ws + WS_BTY); bf16* BTE = (bf16*)(ws + WS_BTE); bf16* AU = (bf16*)(ws + WS_AU); float* EB = (float*)(ws + WS_E);
    bf16* A = (bf16*)(ws + WS_A); float* X1C = (float*)(ws + WS_X1C); bf16* CQ = (bf16*)(ws + WS_CQ); bf16* CKV = (bf16*)(ws + WS_CKV);
    bf16* VF = (bf16*)(ws + WS_V); bf16* ZS = (bf16*)(ws + WS_ZS); bf16* H = (bf16*)(ws + WS_H); float* P = (float*)(ws + WS_P); bf16* QF = (bf16*)(ws + WS_Q); bf16* KF = (bf16*)(ws + WS_K);
    float* RS = (float*)(ws + WS_RS); float* SHWI = (float*)(ws + WS_SHWI); float* SHWG = (float*)(ws + WS_SHWG); bf16* A4 = (bf16*)(ws + WS_A4);
    float* X1 = ap->out;

        if constexpr (ph == 0) {
            LAS float* fl = (LAS float*)lds;
            {
                LAS float* sil = fl;
                LAS float* red = fl + 9 * 1024;
                for (int i = tid; i < 9 * 1024; i += NTHREADS) { const int r = i >> 10, k = i & 1023; const float c = r < NB ? ap->in[I_C][r * DM + k] : ap->in[I_CCTX][k]; sil[i] = c * pg8::sigmoidf_fast(c); }
                __syncthreads();
                const int cgp = tid & 7, kg = tid >> 3;
                for (int item = bx; item < NMODV / 32; item += G) {
                    const int j0 = item * 32 + cgp * 4;
                    f32x4 acc[9];
#pragma unroll
                    for (int r = 0; r < 9; ++r) acc[r] = (f32x4){0.f, 0.f, 0.f, 0.f};
#pragma unroll 4
                    for (int kk = 0; kk < 16; ++kk) { const int k = kg * 16 + kk; const f32x4 w = *(const f32x4*)(ap->in[I_WMOD] + (size_t)k * NMODV + j0);
#pragma unroll
                        for (int r = 0; r < 9; ++r) acc[r] += w * sil[r * 1024 + k]; }
#pragma unroll
                    for (int r = 0; r < 9; ++r) *(LAS f32x4*)(red + (kg * 9 + r) * 32 + cgp * 4) = acc[r];
                    __syncthreads();
                    if (tid < 9 * 32) { const int r = tid >> 5, c = tid & 31; float s = 0.f;
                        for (int q = 0; q < 64; ++q) s += red[(q * 9 + r) * 32 + c];
                        MODS[(size_t)r * NMODV + item * 32 + c] = s + ap->in[I_BMOD][item * 32 + c]; }
                    __syncthreads();
                }
            }
            __syncthreads();
            LAS float* scr = (LAS float*)(lds + wave * 16384);
            {
                const int I1 = (DM / 64) * (2 * DFF / 32), I2 = (DFF / 64) * (DM / 32), I3 = (DM / 64) * (672 / 32);
                for (int it = gw; it < I1 + I2 + I3; it += NGW) {
                    int r = it;
                    if (r < I1) { const int nblk = 2 * DFF / 32, kb = r / nblk, nb = r % nblk; tr_item(ap->in[I_WGU1], 2 * DFF, kb * 64, nb * 32, WGU1, DM, glu_row(nb * 32, DFF), scr, lane); continue; } r -= I1;
                    if (r < I2) { const int nblk = DM / 32, kb = r / nblk, nb = r % nblk; tr_item(ap->in[I_WD1], DM, kb * 64, nb * 32, WD1, DFF, nb * 32, scr, lane); continue; } r -= I2;
                    { const int nblk = 672 / 32, kb = r / nblk, nb = r % nblk; tr_item(ap->in[I_WIN], 672, kb * 64, nb * 32, WIN, DM, nb * 32, scr, lane); }
                }
                const v4u z = {0u, 0u, 0u, 0u};
                for (int i = vcu * NTHREADS + tid; i < 96 * DM / 8; i += G * NTHREADS) *(v4u*)(WIN + (size_t)672 * DM + (size_t)i * 8) = z;
            }
        }
        if constexpr (ph == 1) {
            const int gi = I_GFFN1, msh = 0;
            const float* gvec = ap->in[gi];
            const int nrows = MT;
            for (int r = gw; r < nrows; r += NGW) {
                const bool isc = r >= NLAT; const int mrow = isc ? NB : (r >> 12);
                const float* src = ph == 1 ? (isc ? ap->in[I_CTX] + (size_t)(r - NLAT) * DM : ap->in[I_X] + (size_t)r * DM) : (isc ? X1C + (size_t)(r - NLAT) * DM : X1 + (size_t)r * DM);
                const float* shift = MODS + (size_t)mrow * NMODV + msh * DM; const float* scale = shift + DM;
                f32x4 v[4]; float s = 0.f;
#pragma unroll
                for (int j = 0; j < 4; ++j) { v[j] = *(const f32x4*)(src + 4 * lane + 256 * j); s += (v[j].x * v[j].x + v[j].y * v[j].y) + (v[j].z * v[j].z + v[j].w * v[j].w); }
                const float rinv = 1.0f / sqrtf(wave_sum(s) * (1.0f / DM) + EPS);
#pragma unroll
                for (int j = 0; j < 4; ++j) { const int c = 4 * lane + 256 * j; const f32x4 gg = *(const f32x4*)(gvec + c), sc = *(const f32x4*)(scale + c), sh = *(const f32x4*)(shift + c);
                    const f32x4 y = v[j] * rinv * gg * (sc + 1.0f) + sh; v2u o; o.x = pk2(y.x, y.y); o.y = pk2(y.z, y.w); *(v2u*)(A + (size_t)r * DM + c) = o; }
            }
            shw_items<0, DINP>(gw, NGW, lane, MODS, WIN, (const bf16*)(ws + WS_WGU2), SHWI, SHWG);
        }
        if constexpr (ph == 2 || ph == 14) {
            const int M = ph == 2 ? MT : NLAT;
            pg8::Gemm g{ph == 2 ? A : A4, ph == 2 ? WGU1 : WGU2, DM, DM, DM}; pg8::StaticOrder S; S.init(M, 2 * DFF, G, bx);
            pg8::EpiSwiGLU<ph == 14> E{H, DFF, RS, SHWG};
            pg8::gemm_phase<pg8::EpiSwiGLU<ph == 14>, pg8::StaticOrder, true>(lds, g, S, E);
        }
        if constexpr (ph == 3 || ph == 12 || ph == 15) {
            const int M = ph == 3 ? MT : NLAT;
            pg8::Gemm g{ph == 12 ? A : H, ph == 3 ? WD1 : ph == 12 ? WOUT : WD2, ph == 12 ? DM : DFF, ph == 12 ? DM : DFF, ph == 12 ? DM : DFF};
            pg8::StaticOrder S; S.init(M, DM, G, bx);
            constexpr bool MODE = (ph != 15);
            pg8::EpiResid<MODE> E{ph == 3 ? ap->in[I_X] : X1, X1, ap->in[I_CTX], X1C, MODS + (ph == 3 ? 2 : ph == 12 ? 5 : 8) * DM,
                                  ap->in[ph == 3 ? I_GMIX : I_GFFN2], MODS + (ph == 3 ? 4 : 7) * DM, ph == 3 ? A : A4, RS, ph == 12 ? 1.0f : 0.5f};
            pg8::gemm_phase<pg8::EpiResid<MODE>, pg8::StaticOrder, true>(lds, g, S, E);
            if constexpr (ph == 3) { if (bx >= (MT / 256) * (DM / 256) - 2 * G && G == 256) deferred_prologue(lds_raw, bx - 32, G - 32); else if (G != 256 && bx == 0) {} }
        }
        if constexpr (ph == 5) {
            pg8::Gemm g{A, WIN, DM, DM, DM}; pg8::StaticOrder S; S.init(MT, DINP, G, bx);
            pg8::EpiF32<true> E{P, DINP, 0, RS, SHWI};
            pg8::gemm_phase<pg8::EpiF32<true>, pg8::StaticOrder, true>(lds, g, S, E);
            if (bx >= 152) deferred_fill((bx - 152) * NWAVES + wave, (G - 152) * NWAVES);
        }
        if constexpr (ph == 6) {
            for (int r = gw; r < MT; r += NGW) {
                const float* pr = P + (size_t)r * DINP; const bool isc = r >= NLAT;
                int b, t, key; if (isc) { const int q = r - NLAT; b = q >> 8; t = q & 255; key = t; } else { b = r >> 12; t = r & (SEQ - 1); key = CTXL + t; }
                if (!isc) { const f32x4 v = *(const f32x4*)(pr + 4 * lane); const float s = wave_sum((v.x * v.x + v.y * v.y) + (v.z * v.z + v.w * v.w));
                    const float rinv = 1.0f / sqrtf(s * (1.0f / 256.0f) + EPS); const f32x4 gq = *(const f32x4*)(ap->in[I_GCQ] + 4 * lane); const f32x4 y = v * rinv * gq;
                    v2u o; o.x = pk2(y.x, y.y); o.y = pk2(y.z, y.w); *(v2u*)(CQ + (size_t)r * 256 + 4 * lane) = o; }
                { const f32x2 v = *(const f32x2*)(pr + 256 + 2 * lane); const float s = wave_sum(v.x * v.x + v.y * v.y); const float rinv = 1.0f / sqrtf(s * (1.0f / 128.0f) + EPS);
                  const f32x2 gk = *(const f32x2*)(ap->in[I_GCKV] + 2 * lane); *(unsigned*)(CKV + (size_t)r * 256 + 2 * lane) = pk2(v.x * rinv * gk.x, v.y * rinv * gk.y);
                  *(unsigned*)(CKV + (size_t)r * 256 + 128 + 2 * lane) = 0u; }
                { const int i = lane & 15; const f32x2 v = *(const f32x2*)(pr + 384 + 2 * i); float o1 = v.x, o2 = v.y;
                  if (!isc) { const f32x2 cs = *(const f32x2*)(ROPE + ((size_t)t * 16 + i) * 2); o1 = v.x * cs.x - v.y * cs.y; o2 = v.x * cs.y + v.y * cs.x; }
                  const unsigned w = pk2(o1, o2);
#pragma unroll
                  for (int j = 0; j < 3; ++j) { const int h = (lane >> 4) + 4 * j; *(unsigned*)(KF + ((size_t)(b * NH + h) * SKV + key) * DQK + 64 + 2 * i) = w; } }
                { const f32x4 v = *(const f32x4*)(pr + 416 + 4 * lane); const int g = lane >> 2, ci0 = (lane & 3) * 4;
                  const int rowl = isc ? 512 + b * 4 + (t >> 6) : b * 64 + (t >> 6); const int s = t & 63;
                  v2u o; o.x = pk2(v.x, v.y); o.y = pk2(v.z, v.w); *(v2u*)(AU + ((size_t)g * AUR + rowl) * AUK + s * 16 + ci0) = o; }
            }
        }
        if constexpr (ph == 7) {
            { pg8::Gemm g{CQ, WUQ, 256, 256, 256}; pg8::StaticOrder S; S.init(NLAT, 1280, G, bx); pg8::EpiQ E{QF, ROPE};
              pg8::gemm_phase<pg8::EpiQ, pg8::StaticOrder, true>(lds, g, S, E); }
            { pg8::Gemm g{CKV, WUKV, 256, 256, 256}; pg8::StaticOrder S; S.init(MT, 1536, G, bx); pg8::EpiKV E{KF, VF};
              pg8::gemm_phase<pg8::EpiKV, pg8::StaticOrder, true>(lds, g, S, E); }
            { pg8::Gemm g{AU, BTE, 1024, AUK, 1024}; pg8::OrderE S{G, bx}; pg8::EpiF32<false> E{EB, 256, 1, nullptr, nullptr};
              pg8::gemm_phase<pg8::EpiF32<false>, pg8::OrderE, true>(lds, g, S, E); }
        }
        if constexpr (ph == 8) {
            { const int ci = vcu * NTHREADS + tid;
              if (ci < NB * SG * 2 * SP) { const int p = ci & 63, d = (ci >> 6) & 1, g = (ci >> 7) & 15, b = ci >> 11;
                float lrdt, fr, fi; double rev; s5_par(ap->in[I_LAMRE], ap->in[I_LAMIM], ap->in[I_LOGDT], d, g, p, lrdt, rev, fr, fi);
                float ar, ai; s5_apow(lrdt, rev, CH, ar, ai);
                const float* Eg = EB + (size_t)g * AUR * 256 + d * 128 + 2 * p; bf16* Xg = AU + (size_t)g * AUR * AUK + 1024 + d * 128 + 2 * p;
                float xr = 0.f, xi = 0.f;
                for (int kc = 0; kc < 4; ++kc) { const int c = d == 0 ? kc : 3 - kc; const f32x2 e = *(const f32x2*)(Eg + (size_t)(512 + b * 4 + c) * 256);
                    const float nr = ar * xr - ai * xi + e.x, ni = ar * xi + ai * xr + e.y; xr = nr; xi = ni; }
#pragma unroll 8
                for (int k = 0; k < 64; ++k) { const int c = d == 0 ? k : 63 - k; const f32x2 e = *(const f32x2*)(Eg + (size_t)(b * 64 + c) * 256);
                    *(unsigned*)(Xg + (size_t)(b * 64 + c) * AUK) = pk2(xr, xi);
                    const float nr = ar * xr - ai * xi + e.x, ni = ar * xi + ai * xr + e.y; xr = nr; xi = ni; }
              } }
            for (int i = 0; ; ++i) { const int u = i * G + vcu; if (u >= NB * NH * (SEQ / 256)) break; const int bh = u >> 4, qb = u & 15, b = bh / NH, h = bh - b * NH;
                att::attn_unit(QF + ((size_t)bh * SEQ + qb * 256) * DQK, KF + (size_t)bh * SKV * DQK, VF + (size_t)bh * SKV * DV, A + ((size_t)b * SEQ + qb * 256) * DM + h * DV, DM, (char*)lds_raw); }
        }
        if constexpr (ph == 9) {
            pg8::Gemm g{AU, BTY, AUK, AUK, AUK}; pg8::OrderY S{G, bx}; pg8::EpiY E{ZS};
            pg8::gemm_phase<pg8::EpiY, pg8::OrderY, true>(lds, g, S, E);
        }
        if constexpr (ph == 10) {
            pg8::Gemm g{ZS, WGLU, 256, 256, 256}; pg8::StaticOrder S; S.init(NLAT, 512, G, bx); pg8::EpiGLU E{A, DM, 768};
            pg8::gemm_phase<pg8::EpiGLU, pg8::StaticOrder, true>(lds, g, S, E);
        }
        if constexpr (ph == 11) {
            for (int r = gw; r < NLAT; r += NGW) {
                bf16* row = A + (size_t)r * DM + 16 * lane; v4u w0 = *(const v4u*)row, w1 = *(const v4u*)(row + 8);
                float x[16]; const unsigned ww[8] = {w0.x, w0.y, w0.z, w0.w, w1.x, w1.y, w1.z, w1.w};
#pragma unroll
                for (int q = 0; q < 8; ++q) { x[2 * q] = __builtin_bit_cast(float, ww[q] << 16); x[2 * q + 1] = __builtin_bit_cast(float, ww[q] & 0xffff0000u); }
                float s = 0.f;
#pragma unroll
                for (int q = 0; q < 16; ++q) s += x[q] * x[q];
                const bool isa = lane < 48; const float sa = wave_sum(isa ? s : 0.f), ss = wave_sum(isa ? 0.f : s);
                const float rinv = isa ? 1.0f / sqrtf(sa * (1.0f / 768.0f) + EPS) : 1.0f / sqrtf(ss * (1.0f / 256.0f) + EPS);
                const float* gp = isa ? ap->in[I_GMLA] + 16 * lane : ap->in[I_GSSM] + 16 * (lane - 48);
                unsigned o[8];
#pragma unroll
                for (int q = 0; q < 4; ++q) { const f32x4 gg = *(const f32x4*)(gp + 4 * q); o[2 * q] = pk2(x[4 * q] * rinv * gg.x, x[4 * q + 1] * rinv * gg.y); o[2 * q + 1] = pk2(x[4 * q + 2] * rinv * gg.z, x[4 * q + 3] * rinv * gg.w); }
                *(v4u*)row = (v4u){o[0], o[1], o[2], o[3]}; *(v4u*)(row + 8) = (v4u){o[4], o[5], o[6], o[7]};
            }
        }
        if constexpr (ph == 16) {
            const float* gvec = ap->in[I_GFINAL];
            for (int r = gw; r < NLAT; r += NGW) {
                float* src = X1 + (size_t)r * DM; f32x4 v[4]; float s = 0.f;
#pragma unroll
                for (int j = 0; j < 4; ++j) { v[j] = *(const f32x4*)(src + 4 * lane + 256 * j); s += (v[j].x * v[j].x + v[j].y * v[j].y) + (v[j].z * v[j].z + v[j].w * v[j].w); }
                const float rinv = 1.0f / sqrtf(wave_sum(s) * (1.0f / DM) + EPS);
#pragma unroll
                for (int j = 0; j < 4; ++j) { const int c = 4 * lane + 256 * j; const f32x4 gg = *(const f32x4*)(gvec + c); *(f32x4*)(src + c) = v[j] * rinv * gg; }
            }
        }
}


template <int ph> __global__ void __launch_bounds__(NTHREADS, 2) fwd_ph(Args args) {
    extern __shared__ __attribute__((aligned(16))) unsigned char lds_raw[];
    run_phase<ph>(lds_raw);
}
#if MK_ONE_LAUNCH
__global__ void __launch_bounds__(NTHREADS, 2) fwd_all(Args args) {
    extern __shared__ __attribute__((aligned(16))) unsigned char lds_raw[];
    LAS unsigned char* lds = (LAS unsigned char*)lds_raw;
    const int tid = threadIdx.x;
    for (int u = tid; u < (LDS_BYTES - LDSCTL_OFF) / 4; u += NTHREADS) ((LAS unsigned*)(lds + LDSCTL_OFF))[u] = 0u;
    __syncthreads();
    XcdBarrier bar = xcd_barrier_post((unsigned*)(get_args()->ws + WS_CTL) + 4096, (volatile LAS unsigned*)(lds + LDSCTL_OFF + 64));
    if (get_args()->use_bar == 0x7fffffff) cg::this_grid().sync();
    run_phase<0>(lds_raw); xcd_barrier(bar);
    run_phase<1>(lds_raw); if (PROBE_DUP == 1) { xcd_barrier(bar); run_phase<1>(lds_raw); } xcd_barrier(bar);
    run_phase<2>(lds_raw); if (PROBE_DUP == 2) { xcd_barrier(bar); run_phase<2>(lds_raw); } xcd_barrier(bar);
    run_phase<3>(lds_raw); if (PROBE_DUP == 3) { xcd_barrier(bar); run_phase<3>(lds_raw); } xcd_barrier(bar);
    run_phase<5>(lds_raw); if (PROBE_DUP == 5) { xcd_barrier(bar); run_phase<5>(lds_raw); } xcd_barrier(bar);
    run_phase<6>(lds_raw); if (PROBE_DUP == 6) { xcd_barrier(bar); run_phase<6>(lds_raw); } xcd_barrier(bar);
    run_phase<7>(lds_raw); if (PROBE_DUP == 7) { xcd_barrier(bar); run_phase<7>(lds_raw); } xcd_barrier(bar);
    run_phase<8>(lds_raw); if (PROBE_DUP == 8) { xcd_barrier(bar); run_phase<8>(lds_raw); } xcd_barrier(bar);
    run_phase<9>(lds_raw); if (PROBE_DUP == 9) { xcd_barrier(bar); run_phase<9>(lds_raw); } xcd_barrier(bar);
    run_phase<10>(lds_raw); if (PROBE_DUP == 10) { xcd_barrier(bar); run_phase<10>(lds_raw); } xcd_barrier(bar);
    run_phase<11>(lds_raw); if (PROBE_DUP == 11) { xcd_barrier(bar); run_phase<11>(lds_raw); } xcd_barrier(bar);
    run_phase<12>(lds_raw); if (PROBE_DUP == 12) { xcd_barrier(bar); run_phase<12>(lds_raw); } xcd_barrier(bar);
    run_phase<14>(lds_raw); if (PROBE_DUP == 14) { xcd_barrier(bar); run_phase<14>(lds_raw); } xcd_barrier(bar);
    run_phase<15>(lds_raw); if (PROBE_DUP == 15) { xcd_barrier(bar); run_phase<15>(lds_raw); } xcd_barrier(bar);
    run_phase<16>(lds_raw);
}
#endif

#include <utility>
#if MK_ONE_LAUNCH
#define KFUNC ((const void*)fwd_all)
static bool set_lds_attr() { return hipFuncSetAttribute((const void*)fwd_all, hipFuncAttributeMaxDynamicSharedMemorySize, LDS_BYTES) == hipSuccess; }
#else
#define KFUNC ((const void*)fwd_ph<2>)
template <int... P> static bool set_lds_attr_seq(std::integer_sequence<int, P...>) { bool ok = true; ((ok = ok && hipFuncSetAttribute((const void*)fwd_ph<P>, hipFuncAttributeMaxDynamicSharedMemorySize, LDS_BYTES) == hipSuccess), ...); return ok; }
static bool set_lds_attr() { return set_lds_attr_seq(std::make_integer_sequence<int, NPHASES>{}); }
template <int P> static void launch_one(const Args& a, int grid, hipStream_t stream) { fwd_ph<P><<<dim3(grid), dim3(NTHREADS), LDS_BYTES, stream>>>(a); }
template <int... P> static void launch_all_phases(const Args& a, int grid, hipStream_t stream, std::integer_sequence<int, P...>) { (launch_one<P>(a, grid, stream), ...); }
#endif
extern "C" void kernel_launch(void* const* d_in, const int* in_sizes, int n_in, void* d_out, int out_size, void* d_ws, size_t ws_size, hipStream_t stream) {
    static int grid = 0;
    if (grid == 0) {
        if (n_in != 31 || out_size != NLAT * DM || ws_size < WS_END) { fprintf(stderr, "kernel_launch: unexpected shapes n_in %d out %d ws %zu (need %zu)\n", n_in, out_size, ws_size, (size_t)WS_END); grid = -1; return; }
        int dev = 0, cus = 0, per_cu = 0;
        if (hipGetDevice(&dev) != hipSuccess || hipDeviceGetAttribute(&cus, hipDeviceAttributeMultiprocessorCount, dev) != hipSuccess) { grid = -1; return; }
        if (!set_lds_attr()) { fprintf(stderr, "kernel_launch: hipFuncSetAttribute failed\n"); grid = -1; return; }
        if (hipOccupancyMaxActiveBlocksPerMultiprocessor(&per_cu, KFUNC, NTHREADS, LDS_BYTES) != hipSuccess || per_cu < 1) { fprintf(stderr, "kernel_launch: occupancy query says %d\n", per_cu); per_cu = 1; }
        (void)hipGetLastError();
        if (cus != 256) { fprintf(stderr, "kernel_launch: built for a 256-CU device (got %d)\n", cus); grid = -1; return; }
        grid = cus;
    }
    if (grid < 0) return;
    (void)hipMemsetAsync((char*)d_ws + WS_CTL, 0, CTL_BYTES, stream);
    Args a{};
    for (int i = 0; i < 31; ++i) a.in[i] = (const float*)d_in[i];
    a.out = (float*)d_out; a.ws = (unsigned char*)d_ws;
#if MK_ONE_LAUNCH
    a.ph_lo = 0; a.ph_hi = NPHASES; a.use_bar = 1;
    void* kargs[] = {&a};
    hipError_t e = hipLaunchCooperativeKernel((const void*)fwd_all, dim3(grid), dim3(NTHREADS), kargs, LDS_BYTES, stream);
    if (e != hipSuccess) fprintf(stderr, "kernel_launch: cooperative launch failed: %s (grid %d)\n", hipGetErrorString(e), grid);
#else
    a.ph_lo = 0; a.ph_hi = 1; a.use_bar = 0;
    launch_all_phases(a, grid, stream, std::make_integer_sequence<int, NPHASES>{});
    const hipError_t le = hipPeekAtLastError();
    if (le != hipSuccess) fprintf(stderr, "kernel_launch: launch failed: %s\n", hipGetErrorName(le));
#endif
}
```
